# Optimizing an MI355X kernel written in HIP

```python
import math
import jax, jax.numpy as jnp
from jax import lax
import numpy as np

D_MODEL = 2048
BATCH = 4
SEQ = 2048
DEPTH = 2

MIX_W = 1024
N_BRANCH = 4
CONV_W = 3
CONV_CH = MIX_W
S5_CH = MIX_W
S5_GROUP = 16
S5_GROUPS = S5_CH // S5_GROUP
S5_STATE = 64
SB_HEADS = 8
SB_HEAD_DIM = MIX_W // SB_HEADS
SB_BLOCK = 128
GLA_HEADS = 4
GLA_DK = MIX_W // 2 // GLA_HEADS
GLA_DV = MIX_W // GLA_HEADS
GLA_RANK = 16
GLA_TAU = 16.0
GLA_CHUNK = 16
D_FF = ((-(-8 * D_MODEL // 3)) + 255) // 256 * 256
DEEPNORM_ALPHA = (2.0 * DEPTH) ** 0.25
DEEPNORM_BETA = (8.0 * DEPTH) ** -0.25
IN_SPLITS = (CONV_CH, CONV_CH, CONV_CH,
             S5_CH,
             MIX_W, MIX_W, MIX_W,
             GLA_HEADS * GLA_DK, GLA_HEADS * GLA_DK,
             GLA_HEADS * GLA_DV, GLA_HEADS * GLA_DV,
             GLA_RANK,
             D_MODEL, D_MODEL, D_MODEL, D_MODEL)
IN_WIDTH = sum(IN_SPLITS)

kernel_name = 'hybrid_conv_s5_stickbreak_gla_deepnorm_adaln'


def _layer_norm(x, eps=1e-5):
    x32 = x.astype(jnp.float32)
    mu = jnp.mean(x32, axis=-1, keepdims=True)
    var = jnp.mean(jnp.square(x32 - mu), axis=-1, keepdims=True)
    return ((x32 - mu) * lax.rsqrt(var + eps)).astype(x.dtype)


def _short_conv(b_gate, c_gate, x_in, conv_w):
    h = c_gate * x_in
    y = lax.conv_general_dilated(h, conv_w[:, None, :].astype(h.dtype), (1,), [(CONV_W - 1, 0)],
                                 dimension_numbers=('NWC', 'WIO', 'NWC'),
                                 feature_group_count=h.shape[-1])
    return b_gate * y


def _s5(u, lam_re, lam_im, b_re, b_im, c_re, c_im, d_skip, log_dt):
    f32 = jnp.float32
    bsz, seq, _ = u.shape
    u32 = u.astype(f32)
    ug = u32.reshape(bsz, seq, S5_GROUPS, S5_GROUP)
    lr, li = lam_re.astype(f32), lam_im.astype(f32)
    dt = jnp.exp(log_dt.astype(f32))[:, None]
    mag = jnp.exp(lr * dt)
    ang = li * dt
    ab_re, ab_im = mag * jnp.cos(ang), mag * jnp.sin(ang)
    den = lr * lr + li * li
    nr, ni = ab_re - 1.0, ab_im
    f_re = (nr * lr + ni * li) / den
    f_im = (ni * lr - nr * li) / den
    br, bi = b_re.astype(f32), b_im.astype(f32)
    bb_re = f_re[..., None] * br - f_im[..., None] * bi
    bb_im = f_re[..., None] * bi + f_im[..., None] * br
    xr = jnp.einsum('blgh,gph->blgp', ug, bb_re)
    xi = jnp.einsum('blgh,gph->blgp', ug, bb_im)
    a_re = jnp.broadcast_to(ab_re, xr.shape)
    a_im = jnp.broadcast_to(ab_im, xr.shape)

    def combine(e1, e2):
        a1r, a1i, b1r, b1i = e1
        a2r, a2i, b2r, b2i = e2
        return (a1r * a2r - a1i * a2i,
                a1r * a2i + a1i * a2r,
                a2r * b1r - a2i * b1i + b2r,
                a2r * b1i + a2i * b1r + b2i)

    _, _, sr, si = lax.associative_scan(combine, (a_re, a_im, xr, xi), axis=1)
    y = (jnp.einsum('blgp,ghp->blgh', sr, c_re.astype(f32))
         - jnp.einsum('blgp,ghp->blgh', si, c_im.astype(f32)))
    y = y.reshape(bsz, seq, S5_CH) + d_skip.astype(f32) * u32
    return y.astype(u.dtype)


def _stick_breaking(q, k, v):
    bsz, seq, nh, dh = q.shape
    q = q * dh ** -0.5
    outs = []
    for i in range(seq // SB_BLOCK):
        t0 = i * SB_BLOCK
        kv_len = t0 + SB_BLOCK
        q_blk = q[:, t0:kv_len]
        k_blk, v_blk = k[:, :kv_len], v[:, :kv_len]
        z = jnp.einsum('bthd,bshd->bhts', q_blk, k_blk).astype(jnp.float32)
        t_pos = t0 + jnp.arange(SB_BLOCK)[:, None]
        s_pos = jnp.arange(kv_len)[None, :]
        mask = s_pos < t_pos
        log_beta = jax.nn.log_sigmoid(z)
        log_1m = jnp.where(mask, jax.nn.log_sigmoid(-z), 0.0)
        tail = lax.cumsum(log_1m, axis=3, reverse=True) - log_1m
        w = jnp.where(mask, jnp.exp(log_beta + tail), 0.0)
        outs.append(jnp.einsum('bhts,bshd->bthd', w.astype(v.dtype), v_blk))
    return jnp.concatenate(outs, axis=1)


def _gla_chunked(q, k, v, log_a):
    f32 = jnp.float32
    bsz, seq, nh, dk = q.shape
    dv = v.shape[-1]
    n = seq // GLA_CHUNK

    def chunks(t):
        return t.astype(f32).reshape(bsz, n, GLA_CHUNK, nh, t.shape[-1]).transpose(0, 3, 1, 2, 4)

    qc = chunks(q) * dk ** -0.5
    kc, vc, la = chunks(k), chunks(v), chunks(log_a)
    b = jnp.cumsum(la, axis=3)
    causal = jnp.tril(jnp.ones((GLA_CHUNK, GLA_CHUNK), bool))
    diff = b[:, :, :, :, None, :] - b[:, :, :, None, :, :]
    decay = jnp.exp(jnp.where(causal[:, :, None], diff, -jnp.inf))
    scores = jnp.einsum('bhntk,bhnsk,bhntsk->bhnts', qc, kc, decay)
    o_intra = jnp.einsum('bhnts,bhnsv->bhntv', scores, vc)
    b_end = b[:, :, :, -1:, :]
    q_dec = qc * jnp.exp(b)
    k_dec = kc * jnp.exp(b_end - b)
    a_end = jnp.exp(b_end[:, :, :, 0, :])

    def step(state, inp):
        q_n, k_n, v_n, a_n = inp
        o_n = jnp.einsum('bhtk,bhkv->bhtv', q_n, state)
        state = a_n[..., None] * state + jnp.einsum('bhsk,bhsv->bhkv', k_n, v_n)
        return state, o_n

    xs = (jnp.moveaxis(q_dec, 2, 0), jnp.moveaxis(k_dec, 2, 0),
          jnp.moveaxis(vc, 2, 0), jnp.moveaxis(a_end, 2, 0))
    s0 = jnp.zeros((bsz, nh, dk, dv), f32)
    _, o_inter = lax.scan(step, s0, xs)
    o = o_intra + jnp.moveaxis(o_inter, 0, 2)
    return o.transpose(0, 2, 3, 1, 4).reshape(bsz, seq, nh, dv).astype(q.dtype)


def _hybrid_mixer(h, w_in, conv_w, w_conv_out, lam_re, lam_im, b_re, b_im, c_re, c_im, d_skip,
                  log_dt, w_s5_val, w_s5_gate, w_sb_out, gla_w_gate, gla_b_gate, gla_norm_g,
                  w_gla_out, w_o):
    bsz, seq, _ = h.shape
    proj = h @ w_in
    split_at = np.cumsum(IN_SPLITS)[:-1].tolist()
    (cv_b, cv_c, cv_x, s5_u, sb_q, sb_k, sb_v, gl_q, gl_k, gl_v, gl_r, gl_lr,
     g_conv, g_s5, g_sb, g_gla) = jnp.split(proj, split_at, axis=-1)

    def heads(t, nh):
        return t.reshape(bsz, seq, nh, -1)

    y_conv = _short_conv(cv_b, cv_c, cv_x, conv_w) @ w_conv_out
    s = jax.nn.gelu(_s5(s5_u, lam_re, lam_im, b_re, b_im, c_re, c_im, d_skip, log_dt))
    y_s5 = (s @ w_s5_val) * jax.nn.sigmoid(s @ w_s5_gate)
    o_sb = _stick_breaking(heads(sb_q, SB_HEADS), heads(sb_k, SB_HEADS), heads(sb_v, SB_HEADS))
    y_sb = o_sb.reshape(bsz, seq, MIX_W) @ w_sb_out
    log_a = jax.nn.log_sigmoid((gl_lr @ gla_w_gate + gla_b_gate).astype(jnp.float32)) / GLA_TAU
    o_gla = _gla_chunked(heads(gl_q, GLA_HEADS), heads(gl_k, GLA_HEADS), heads(gl_v, GLA_HEADS),
                         log_a.reshape(bsz, seq, GLA_HEADS, GLA_DK))
    o_gla = _layer_norm(o_gla) * gla_norm_g.reshape(GLA_HEADS, GLA_DV)
    y_gla = (o_gla.reshape(bsz, seq, MIX_W) * jax.nn.silu(gl_r)) @ w_gla_out
    merged = (jax.nn.sigmoid(g_conv) * y_conv + jax.nn.sigmoid(g_s5) * y_s5
              + jax.nn.sigmoid(g_sb) * y_sb + jax.nn.sigmoid(g_gla) * y_gla)
    return merged @ w_o


def setup_inputs(seed: int = 0) -> dict:
    key = jax.random.key(seed)
    ks = jax.random.split(key, 32)
    f32 = jnp.float32

    def nrm(i, shape, scale):
        return jax.random.normal(ks[i], shape, f32) * scale

    L, D = DEPTH, D_MODEL
    G, P, H = S5_GROUPS, S5_STATE, S5_GROUP
    return {
        'x': nrm(0, (BATCH, SEQ, D), 1.0),
        'c': nrm(1, (BATCH, D), 1.0),
        'ada_w': nrm(2, (L, D, 6 * D), 0.5 * D ** -0.5),
        'ada_b': nrm(3, (L, 6 * D), 0.02),
        'w_in': nrm(4, (L, D, IN_WIDTH), D ** -0.5),
        'conv_w': nrm(5, (L, CONV_W, CONV_CH), CONV_W ** -0.5),
        'w_conv_out': nrm(6, (L, CONV_CH, D), CONV_CH ** -0.5),
        's5_lam_re': -0.5 + nrm(7, (L, G, P), 0.01),
        's5_lam_im': jnp.pi * jnp.arange(P, dtype=f32) + nrm(8, (L, G, P), 0.01),
        's5_b_re': nrm(9, (L, G, P, H), (2 * H) ** -0.5),
        's5_b_im': nrm(10, (L, G, P, H), (2 * H) ** -0.5),
        's5_c_re': nrm(11, (L, G, H, P), P ** -0.5),
        's5_c_im': nrm(12, (L, G, H, P), P ** -0.5),
        's5_d': nrm(13, (L, S5_CH), 1.0),
        's5_log_dt': jax.random.uniform(ks[14], (L, G), f32, math.log(1e-3), math.log(1e-1)),
        'w_s5_val': nrm(15, (L, S5_CH, D), S5_CH ** -0.5),
        'w_s5_gate': nrm(16, (L, S5_CH, D), S5_CH ** -0.5),
        'w_sb_out': nrm(17, (L, MIX_W, D), MIX_W ** -0.5),
        'gla_w_gate': nrm(18, (L, GLA_RANK, GLA_HEADS * GLA_DK), GLA_RANK ** -0.5),
        'gla_b_gate': nrm(19, (L, GLA_HEADS * GLA_DK), 0.1),
        'gla_norm_g': 1.0 + nrm(20, (L, GLA_HEADS * GLA_DV), 0.02),
        'w_gla_out': nrm(21, (L, MIX_W, D), MIX_W ** -0.5),
        'w_o': nrm(22, (L, D, D), DEEPNORM_BETA * D ** -0.5),
        'ln1_g': 1.0 + nrm(23, (L, D), 0.02),
        'ln1_b': nrm(24, (L, D), 0.02),
        'ffn_w_gate': nrm(25, (L, D, D_FF), D ** -0.5),
        'ffn_w_up': nrm(26, (L, D, D_FF), D ** -0.5),
        'ffn_w_down': nrm(27, (L, D_FF, D), DEEPNORM_BETA * D_FF ** -0.5),
        'ln2_g': 1.0 + nrm(28, (L, D), 0.02),
        'ln2_b': nrm(29, (L, D), 0.02),
    }


def reference(x, c, ada_w, ada_b, w_in, conv_w, w_conv_out, s5_lam_re, s5_lam_im, s5_b_re, s5_b_im,
              s5_c_re, s5_c_im, s5_d, s5_log_dt, w_s5_val, w_s5_gate, w_sb_out, gla_w_gate,
              gla_b_gate, gla_norm_g, w_gla_out, w_o, ln1_g, ln1_b, ffn_w_gate, ffn_w_up,
              ffn_w_down, ln2_g, ln2_b):
    for l in range(DEPTH):
        mod = jax.nn.silu(c) @ ada_w[l] + ada_b[l]
        sh1, sc1, gt1, sh2, sc2, gt2 = [m[:, None, :] for m in jnp.split(mod, 6, axis=-1)]
        h = _layer_norm(x) * (1.0 + sc1) + sh1
        mix = _hybrid_mixer(h, w_in[l], conv_w[l], w_conv_out[l], s5_lam_re[l], s5_lam_im[l],
                            s5_b_re[l], s5_b_im[l], s5_c_re[l], s5_c_im[l], s5_d[l], s5_log_dt[l],
                            w_s5_val[l], w_s5_gate[l], w_sb_out[l], gla_w_gate[l], gla_b_gate[l],
                            gla_norm_g[l], w_gla_out[l], w_o[l])
        x = _layer_norm(DEEPNORM_ALPHA * x + gt1 * mix) * ln1_g[l] + ln1_b[l]
        h = _layer_norm(x) * (1.0 + sc2) + sh2
        ff = (jax.nn.silu(h @ ffn_w_gate[l]) * (h @ ffn_w_up[l])) @ ffn_w_down[l]
        x = _layer_norm(DEEPNORM_ALPHA * x + gt2 * ff) * ln2_g[l] + ln2_b[l]
    return x
```

```cpp
#include <hip/hip_runtime.h>
#include <hip/hip_cooperative_groups.h>
#include <cstdio>
#include <cstdint>
namespace cg = cooperative_groups;

#define LAS __attribute__((address_space(3)))
typedef unsigned short bf16_t;
typedef short bf16x8 __attribute__((ext_vector_type(8)));
typedef short s16x4 __attribute__((ext_vector_type(4)));
typedef float f32x4 __attribute__((ext_vector_type(4)));
typedef unsigned u32x4 __attribute__((ext_vector_type(4)));
typedef unsigned u32x2 __attribute__((ext_vector_type(2)));

constexpr int DM = 2048, NB = 4, SEQ = 2048, MTOK = NB * SEQ, NPROJ = 18688, NIN = 18448, DFF = 5632, NGU = 2 * DFF;
constexpr int C_CVB = 0, C_CVC = 1024, C_CVX = 2048, C_S5U = 3072, C_SBQ = 4096, C_SBK = 5120, C_SBV = 6144, C_GLQ = 7168,
              C_GLK = 7680, C_GLV = 8192, C_GLR = 9216, C_GCONV = 10240, C_GS5 = 12288, C_GSB = 14336, C_GGLA = 16384, C_GLLR = 18432;
constexpr int BR_CONV = 0, BR_S5 = 1024, BR_SB = 2048, BR_GLA = 3072, NBR = 4096;
constexpr float ALPHA = 1.41421356237f;
constexpr float QSCALE = 0.08838834764831845f;

constexpr size_t MiB = 1u << 20;
constexpr size_t W_LAYER = 167 * MiB;
constexpr size_t WO_WIN = 0, WO_WBR = 73 * MiB, WO_WO = 93 * MiB, WO_WGU = 101 * MiB, WO_WD = 145 * MiB;
constexpr size_t WS_W = 0;
constexpr size_t WS_S5M = 334 * MiB;
constexpr size_t S5_LAYER = 17 * MiB, S5O_MROW = 0, S5O_MIN = 12 * MiB, S5O_A16 = 16 * MiB;
constexpr size_t WS_MOD = 368 * MiB;
constexpr size_t WS_H = 369 * MiB;
constexpr size_t WS_PROJ = 401 * MiB;
constexpr size_t WS_ACT = WS_PROJ;
constexpr size_t WS_BR = 693 * MiB;
constexpr size_t WS_Y = 757 * MiB;
constexpr size_t WS_MB = 821 * MiB;
constexpr size_t WS_X1 = 853 * MiB;
constexpr size_t WS_SLOC = 917 * MiB;
constexpr size_t WS_SPREV = 933 * MiB;
constexpr size_t WS_BCUM = 941 * MiB;
constexpr size_t WS_AEND = 957 * MiB;
constexpr size_t WS_LCT = 958 * MiB;
constexpr size_t WS_SNT = 1022 * MiB;
constexpr size_t WS_END = 1054 * MiB;

constexpr int LDS_BYTES = 147456;

__device__ __forceinline__ float bf2f(unsigned u) { return __builtin_bit_cast(float, u << 16); }
__device__ __forceinline__ unsigned f2bf(float f) { unsigned u = __builtin_bit_cast(unsigned, f); return (u + 0x7fffu + ((u >> 16) & 1u)) >> 16; }
__device__ __forceinline__ unsigned pk2(float lo, float hi) { return f2bf(lo) | (f2bf(hi) << 16); }
__device__ __forceinline__ float lo16(unsigned w) { return __builtin_bit_cast(float, w << 16); }
__device__ __forceinline__ float hi16(unsigned w) { return __builtin_bit_cast(float, w & 0xffff0000u); }
__device__ __forceinline__ float sigm(float x) { return 1.f / (1.f + __expf(-x)); }
__device__ __forceinline__ float siluf_(float x) { return x / (1.f + __expf(-x)); }
__device__ __forceinline__ float gelu_tanh(float x) { float u = 0.7978845608028654f * (x + 0.044715f * x * x * x); float t = 1.f - 2.f / (1.f + __expf(2.f * u)); return 0.5f * x * (1.f + t); }
__device__ __forceinline__ float softplusf_(float z) { return fmaxf(z, 0.f) + __logf(1.f + __expf(-fabsf(z))); }
__device__ __forceinline__ float wave_sum(float v) {
#pragma unroll
    for (int o = 1; o < 64; o <<= 1) v += __shfl_xor(v, o);
    return v;
}
#define MFMA16(a, b, c) __builtin_amdgcn_mfma_f32_16x16x32_bf16((a), (b), (c), 0, 0, 0)

namespace pg8 {
constexpr int BM = 256, BK = 64, HALF = 128, HTB = HALF * BK * 2, NXCD = 8, WGM = 8;
__host__ __device__ __forceinline__ int lds_byte(int r, int c) { const int st = (r >> 4) * 2 + (c >> 5), rr = r & 15, cc = c & 31, ob = rr * 64 + cc * 2; return st * 1024 + (ob ^ (((ob >> 9) & 1) << 5)); }
__host__ __device__ __forceinline__ void stage_rc(int b, int& R, int& C) { const int st = b / 1024, sb = b % 1024, swz = sb ^ (((sb >> 9) & 1) << 5); R = (st >> 1) * 16 + swz / 64; C = (st & 1) * 32 + (swz % 64) / 2; }
__host__ __device__ __forceinline__ int perm32(int rho) { const int n = rho >> 4, i = rho & 15; return 8 * (i >> 2) + 4 * n + (i & 3); }

struct Unit { int pm, pn, acol, mode; };
struct Gemm { const bf16_t* A; const bf16_t* Bt; int lda, ldb, K; };

struct StaticOrder {
    int nM, nN, nwg, G, c;
    __device__ void init(int M, int N, int G_, int c_) { nM = M / BM; nN = N / BM; nwg = nM * nN; G = G_; c = c_; }
    __device__ bool next(int i, Unit& u) const {
        const long L = (long)i * G + c; if (L >= nwg) return false;
        int wgid = (int)L; { const int q = nwg / NXCD, r = nwg % NXCD, xcd = wgid % NXCD, off = wgid / NXCD; wgid = (xcd < r ? xcd * (q + 1) : r * (q + 1) + (xcd - r) * q) + off; }
        const int nig = WGM * nN, gid = wgid / nig, fm = gid * WGM, gsz = (nM - fm) < WGM ? (nM - fm) : WGM;
        u.pm = fm + ((wgid % nig) % gsz); u.pn = (wgid % nig) / gsz; u.acol = 0; u.mode = 0; return true;
    }
};
struct BranchOrder {
    int G, c;
    __device__ bool next(int i, Unit& u) const {
        const int L = (i / 5) * G + c; if (L >= 256) return false;
        const int sub = i % 5, pn8 = L & 7; u.pm = L >> 3;
        if (sub == 0) { u.pn = pn8; u.acol = BR_CONV; u.mode = 0; }
        else if (sub == 1) { u.pn = 8 + pn8; u.acol = BR_SB; u.mode = 1; }
        else if (sub == 2) { u.pn = 16 + pn8; u.acol = BR_GLA; u.mode = 2; }
        else { u.pn = 24 + 2 * pn8 + (sub - 3); u.acol = BR_S5; u.mode = 3; }
        return true;
    }
};

template <class Epi, class Sched>
__device__ __forceinline__ void gemm_phase(LAS unsigned char* lds, const Gemm g, const Sched& S, const Epi& E, int tid) {
    const int wid = __builtin_amdgcn_readfirstlane(tid >> 6), lane = tid & 63, wr = wid >> 2, wc = wid & 3, fr = lane & 15, fq = lane >> 4;
    const int K = g.K, nt = K / BK;
    unsigned voffA[2], voffB[2];
#pragma unroll
    for (int i = 0; i < 2; ++i) { int R, C; stage_rc(tid * 16 + i * 8192, R, C); const int Rb = (R & ~31) + perm32(R & 31);
        voffA[i] = (unsigned)(R * g.lda + C) * 2u; voffB[i] = (unsigned)(Rb * g.ldb + C) * 2u; }
    const size_t kstep = (size_t)(BK * 2);
    const size_t hstepA = (size_t)HALF * g.lda * 2, hstepB = (size_t)HALF * g.ldb * 2;
    const size_t tstepA = 2 * hstepA, tstepB = 2 * hstepB;
    const unsigned ldsw = (unsigned)wid * 1024u;
    const int aoff = lds_byte(wr * 64 + fr, fq * 8), boff = lds_byte(wc * 32 + fr, fq * 8);
#define PG8_SA(b, h) (((b) * 2 + (h)) * HTB)
#define PG8_SB(b, h) ((4 + (b) * 2 + (h)) * HTB)
#define PG8_STAGE(bufoff, gbase, voff) do { _Pragma("unroll") for (int _i = 0; _i < 2; ++_i) \
        __builtin_amdgcn_global_load_lds((const unsigned*)((const char*)(gbase) + (voff)[_i]), (LAS unsigned*)(lds + (bufoff) + ldsw + _i * 8192), 16, 0, 0); } while (0)
#define PG8_LDA(dst, b, h) do { _Pragma("unroll") for (int m = 0; m < 4; ++m) _Pragma("unroll") for (int k = 0; k < 2; ++k) dst[m][k] = *(const LAS bf16x8*)(lds + PG8_SA(b, h) + aoff + m * 2048 + k * 1024); } while (0)
#define PG8_LDB(dst, b, h) do { _Pragma("unroll") for (int n = 0; n < 2; ++n) _Pragma("unroll") for (int k = 0; k < 2; ++k) dst[n][k] = *(const LAS bf16x8*)(lds + PG8_SB(b, h) + boff + n * 2048 + k * 1024); } while (0)
#define PG8_MMA(ai, bj, At, Bt) do { __builtin_amdgcn_s_setprio(1); _Pragma("unroll") for (int m = 0; m < 4; ++m) _Pragma("unroll") for (int n = 0; n < 2; ++n) _Pragma("unroll") for (int k = 0; k < 2; ++k) \
        acc[ai][bj][m][n] = __builtin_amdgcn_mfma_f32_16x16x32_bf16(Bt[n][k], At[m][k], acc[ai][bj][m][n], 0, 0, 0); __builtin_amdgcn_s_setprio(0); } while (0)
#define PG8_WAIT_V(n) asm volatile("s_waitcnt vmcnt(" #n ")" ::: "memory")
#define PG8_WAIT_L(n) asm volatile("s_waitcnt lgkmcnt(" #n ")" ::: "memory")
#define PG8_BAR __builtin_amdgcn_s_barrier()
#define PG8_SCHED __builtin_amdgcn_sched_barrier(0)
    Unit cur, nxt; int ui = 0;
    if (!S.next(0, cur)) return;
    f32x4 acc[2][2][4][2];
#pragma unroll
    for (int a = 0; a < 2; ++a)
#pragma unroll
        for (int b = 0; b < 2; ++b)
#pragma unroll
            for (int m = 0; m < 4; ++m)
#pragma unroll
                for (int n = 0; n < 2; ++n) acc[a][b][m][n] = (f32x4){0.f, 0.f, 0.f, 0.f};
    bf16x8 At[4][2], B0[2][2], B1[2][2];
    const char* cA = (const char*)g.A + (size_t)cur.pm * tstepA + (size_t)cur.acol * 2; const char* cB = (const char*)g.Bt + (size_t)cur.pn * tstepB;
    PG8_STAGE(PG8_SB(0, 0), cB, voffB); PG8_STAGE(PG8_SB(0, 1), cB + hstepB, voffB); PG8_STAGE(PG8_SA(0, 0), cA, voffA); PG8_STAGE(PG8_SA(0, 1), cA + hstepA, voffA);
    if (wr == 1) PG8_BAR;
    PG8_WAIT_V(2); PG8_BAR;
    PG8_STAGE(PG8_SB(1, 0), cB + kstep, voffB); PG8_STAGE(PG8_SA(1, 0), cA + kstep, voffA); PG8_STAGE(PG8_SB(1, 1), cB + hstepB + kstep, voffB);
    PG8_WAIT_V(6); PG8_BAR;
    for (;;) {
        const bool has_next = S.next(ui + 1, nxt);
        const char* nA = has_next ? (const char*)g.A + (size_t)nxt.pm * tstepA + (size_t)nxt.acol * 2 : cA; const char* nB = has_next ? (const char*)g.Bt + (size_t)nxt.pn * tstepB : cB;
        for (int t = 0; t < nt; t += 2) {
            const bool last = (t == nt - 2);
            const char* a1 = cA + (size_t)(t + 1) * kstep;
            const char* a2 = last ? nA : cA + (size_t)(t + 2) * kstep; const char* b2 = last ? nB : cB + (size_t)(t + 2) * kstep;
            const char* a3 = a2 + kstep; const char* b3 = b2 + kstep;
            PG8_LDB(B0, 0, 0); PG8_LDB(B1, 0, 1); PG8_SCHED; PG8_LDA(At, 0, 0); PG8_STAGE(PG8_SA(1, 1), a1 + hstepA, voffA);
            PG8_WAIT_V(8); PG8_WAIT_L(0); PG8_BAR; PG8_MMA(0, 0, At, B0); PG8_MMA(0, 1, At, B1); PG8_BAR; PG8_SCHED;
            PG8_LDA(At, 0, 1); PG8_STAGE(PG8_SB(0, 0), b2, voffB); PG8_STAGE(PG8_SB(0, 1), b2 + hstepB, voffB); PG8_STAGE(PG8_SA(0, 0), a2, voffA);
            PG8_WAIT_V(8); PG8_WAIT_L(0); PG8_BAR; PG8_MMA(1, 0, At, B0); PG8_MMA(1, 1, At, B1); PG8_BAR; PG8_SCHED;
            PG8_LDB(B0, 1, 0); PG8_LDB(B1, 1, 1); PG8_SCHED; PG8_LDA(At, 1, 0); PG8_STAGE(PG8_SA(0, 1), a2 + hstepA, voffA);
            PG8_WAIT_V(8); PG8_WAIT_L(0); PG8_BAR; PG8_MMA(0, 0, At, B0); PG8_MMA(0, 1, At, B1); PG8_BAR; PG8_SCHED;
            PG8_LDA(At, 1, 1); PG8_STAGE(PG8_SB(1, 0), b3, voffB); PG8_STAGE(PG8_SB(1, 1), b3 + hstepB, voffB); PG8_STAGE(PG8_SA(1, 0), a3, voffA);
            PG8_WAIT_V(8); PG8_WAIT_L(0); PG8_BAR; PG8_MMA(1, 0, At, B0); PG8_MMA(1, 1, At, B1); PG8_BAR; PG8_SCHED;
        }
        E(acc, cur, wr, wc, fr, fq);
        if (!has_next) break;
#pragma unroll
        for (int a = 0; a < 2; ++a)
#pragma unroll
            for (int b = 0; b < 2; ++b)
#pragma unroll
                for (int m = 0; m < 4; ++m)
#pragma unroll
                    for (int n = 0; n < 2; ++n) acc[a][b][m][n] = (f32x4){0.f, 0.f, 0.f, 0.f};
        cur = nxt; cA = nA; cB = nB; ++ui;
    }
    PG8_WAIT_V(0);
    if (wr == 0) PG8_BAR;
    PG8_BAR;
#undef PG8_SA
#undef PG8_SB
#undef PG8_STAGE
#undef PG8_LDA
#undef PG8_LDB
#undef PG8_MMA
#undef PG8_WAIT_V
#undef PG8_WAIT_L
#undef PG8_BAR
#undef PG8_SCHED
}

struct EpiBf16 {
    bf16_t* O; int ldc;
    __device__ __forceinline__ void operator()(const f32x4 (&acc)[2][2][4][2], const Unit& u, int wr, int wc, int fr, int fq) const {
        const int row0 = u.pm * BM + wr * 64 + fr, col0 = u.pn * BM + wc * 32 + 8 * fq;
#pragma unroll
        for (int ai = 0; ai < 2; ++ai)
#pragma unroll
            for (int m = 0; m < 4; ++m) { bf16_t* rowp = O + (size_t)(row0 + ai * HALF + m * 16) * ldc + col0;
#pragma unroll
                for (int bj = 0; bj < 2; ++bj) { const f32x4 v0 = acc[ai][bj][m][0], v1 = acc[ai][bj][m][1];
                    u32x4 w; w.x = pk2(v0[0], v0[1]); w.y = pk2(v0[2], v0[3]); w.z = pk2(v1[0], v1[1]); w.w = pk2(v1[2], v1[3]);
                    *(u32x4*)(rowp + bj * HALF) = w; } }
    }
};
struct EpiGateUp {
    bf16_t* O;
    __device__ __forceinline__ void operator()(const f32x4 (&acc)[2][2][4][2], const Unit& u, int wr, int wc, int fr, int fq) const {
        const int row0 = u.pm * BM + wr * 64 + fr, col0 = u.pn * HALF + wc * 32 + 8 * fq;
#pragma unroll
        for (int ai = 0; ai < 2; ++ai)
#pragma unroll
            for (int m = 0; m < 4; ++m) { bf16_t* rowp = O + (size_t)(row0 + ai * HALF + m * 16) * DFF + col0;
                float r[8];
#pragma unroll
                for (int n = 0; n < 2; ++n)
#pragma unroll
                    for (int i = 0; i < 4; ++i) r[n * 4 + i] = siluf_(acc[ai][0][m][n][i]) * acc[ai][1][m][n][i];
                u32x4 w; w.x = pk2(r[0], r[1]); w.y = pk2(r[2], r[3]); w.z = pk2(r[4], r[5]); w.w = pk2(r[6], r[7]);
                *(u32x4*)rowp = w; }
    }
};
struct EpiResid {
    const float* X; const float* gate; float* Y;
    __device__ __forceinline__ void operator()(const f32x4 (&acc)[2][2][4][2], const Unit& u, int wr, int wc, int fr, int fq) const {
        const int row0 = u.pm * BM + wr * 64 + fr, col0 = u.pn * BM + wc * 32 + 8 * fq;
        const float* gp = gate + (size_t)(u.pm >> 3) * 12288 + col0;
#pragma unroll
        for (int bj = 0; bj < 2; ++bj) {
            const f32x4 g0 = *(const f32x4*)(gp + bj * HALF), g1 = *(const f32x4*)(gp + bj * HALF + 4);
#pragma unroll
            for (int ai = 0; ai < 2; ++ai)
#pragma unroll
                for (int m = 0; m < 4; ++m) { const size_t off = (size_t)(row0 + ai * HALF + m * 16) * DM + col0 + bj * HALF;
                    const f32x4 x0 = *(const f32x4*)(X + off), x1 = *(const f32x4*)(X + off + 4);
                    *(f32x4*)(Y + off) = x0 * ALPHA + g0 * acc[ai][bj][m][0];
                    *(f32x4*)(Y + off + 4) = x1 * ALPHA + g1 * acc[ai][bj][m][1]; }
        }
    }
};
struct EpiBranch {
    const bf16_t* P; float* MG; bf16_t* MBF;
    __device__ __forceinline__ void operator()(const f32x4 (&acc)[2][2][4][2], const Unit& u, int wr, int wc, int fr, int fq) const {
        const int row0 = u.pm * BM + wr * 64 + fr;
        if (u.mode < 3) {
            const int col0 = u.pn * BM - u.mode * 2048 + wc * 32 + 8 * fq;
            const int gcol = (u.mode == 0 ? C_GCONV : (u.mode == 1 ? C_GSB : C_GGLA));
#pragma unroll
            for (int ai = 0; ai < 2; ++ai)
#pragma unroll
                for (int m = 0; m < 4; ++m) { const int row = row0 + ai * HALF + m * 16;
#pragma unroll
                    for (int bj = 0; bj < 2; ++bj) { const int c = col0 + bj * HALF;
                        const u32x4 gw = *(const u32x4*)(P + (size_t)row * NPROJ + gcol + c);
                        f32x4 r0, r1;
                        r0[0] = sigm(lo16(gw.x)) * acc[ai][bj][m][0][0]; r0[1] = sigm(hi16(gw.x)) * acc[ai][bj][m][0][1];
                        r0[2] = sigm(lo16(gw.y)) * acc[ai][bj][m][0][2]; r0[3] = sigm(hi16(gw.y)) * acc[ai][bj][m][0][3];
                        r1[0] = sigm(lo16(gw.z)) * acc[ai][bj][m][1][0]; r1[1] = sigm(hi16(gw.z)) * acc[ai][bj][m][1][1];
                        r1[2] = sigm(lo16(gw.w)) * acc[ai][bj][m][1][2]; r1[3] = sigm(hi16(gw.w)) * acc[ai][bj][m][1][3];
                        float* mp = MG + (size_t)row * DM + c;
                        if (u.mode != 0) { r0 += *(const f32x4*)mp; r1 += *(const f32x4*)(mp + 4); }
                        *(f32x4*)mp = r0; *(f32x4*)(mp + 4) = r1; } }
        } else {
            const int col0 = (u.pn - 24) * HALF + wc * 32 + 8 * fq;
#pragma unroll
            for (int ai = 0; ai < 2; ++ai)
#pragma unroll
                for (int m = 0; m < 4; ++m) { const int row = row0 + ai * HALF + m * 16;
                    const u32x4 gw = *(const u32x4*)(P + (size_t)row * NPROJ + C_GS5 + col0);
                    const float* mp = MG + (size_t)row * DM + col0;
                    const f32x4 m0 = *(const f32x4*)mp, m1 = *(const f32x4*)(mp + 4);
                    float r[8];
                    r[0] = m0[0] + sigm(lo16(gw.x)) * acc[ai][0][m][0][0] * sigm(acc[ai][1][m][0][0]);
                    r[1] = m0[1] + sigm(hi16(gw.x)) * acc[ai][0][m][0][1] * sigm(acc[ai][1][m][0][1]);
                    r[2] = m0[2] + sigm(lo16(gw.y)) * acc[ai][0][m][0][2] * sigm(acc[ai][1][m][0][2]);
                    r[3] = m0[3] + sigm(hi16(gw.y)) * acc[ai][0][m][0][3] * sigm(acc[ai][1][m][0][3]);
                    r[4] = m1[0] + sigm(lo16(gw.z)) * acc[ai][0][m][1][0] * sigm(acc[ai][1][m][1][0]);
                    r[5] = m1[1] + sigm(hi16(gw.z)) * acc[ai][0][m][1][1] * sigm(acc[ai][1][m][1][1]);
                    r[6] = m1[2] + sigm(lo16(gw.w)) * acc[ai][0][m][1][2] * sigm(acc[ai][1][m][1][2]);
                    r[7] = m1[3] + sigm(hi16(gw.w)) * acc[ai][0][m][1][3] * sigm(acc[ai][1][m][1][3]);
                    u32x4 w; w.x = pk2(r[0], r[1]); w.y = pk2(r[2], r[3]); w.z = pk2(r[4], r[5]); w.w = pk2(r[6], r[7]);
                    *(u32x4*)(MBF + (size_t)row * DM + col0) = w; }
        }
    }
};
}

struct Args { const float* in[30]; float* out; unsigned char* ws; int ph_lo, ph_hi; };
enum { I_X = 0, I_C, I_ADAW, I_ADAB, I_WIN, I_CONVW, I_WCO, I_LRE, I_LIM, I_BRE, I_BIM, I_CRE, I_CIM, I_S5D, I_LOGDT, I_WS5V, I_WS5G, I_WSB,
       I_GLAWG, I_GLABG, I_GLANG, I_WGLA, I_WO, I_LN1G, I_LN1B, I_FFG, I_FFU, I_FFD, I_LN2G, I_LN2B };

__device__ __forceinline__ void tr_item(const float* srcp, int ld, int k0, bf16_t* WT, int Kd, int n0, float* scr, int lane) {
#pragma unroll 8
    for (int i = 0; i < 32; ++i) { const int kk = 2 * i + (lane >> 5); scr[kk * 33 + (lane & 31)] = srcp ? srcp[(size_t)(k0 + kk) * ld] : 0.f; }
    __builtin_amdgcn_s_waitcnt(0); asm volatile("" ::: "memory");
    const int c = lane & 7;
#pragma unroll
    for (int j = 0; j < 4; ++j) { const int n = (lane >> 3) + 8 * j; const float* s = scr + (8 * c) * 33 + n;
        u32x4 o; o.x = pk2(s[0 * 33], s[1 * 33]); o.y = pk2(s[2 * 33], s[3 * 33]); o.z = pk2(s[4 * 33], s[5 * 33]); o.w = pk2(s[6 * 33], s[7 * 33]);
        *(u32x4*)(WT + (size_t)(n0 + n) * Kd + k0 + 8 * c) = o; }
    __builtin_amdgcn_s_waitcnt(0); asm volatile("" ::: "memory");
}

__device__ __forceinline__ void p0_transposes(const Args& a, unsigned char* smem, int gw, int ngw, int wave, int lane) {
    float* scr = (float*)(smem + wave * 8448);
    constexpr int C0 = 32 * 584, C1 = 16 * 320, C2 = 32 * 64, C3 = 32 * 352, C4 = 88 * 64, CL = C0 + C1 + C2 + C3 + C4;
    for (int it = gw; it < 2 * CL; it += ngw) {
        const int l = it / CL; int r = it % CL;
        unsigned char* wl = a.ws + WS_W + (size_t)l * W_LAYER;
        const int nl = lane & 31;
        if (r < C0) { const int kb = r / 584, nb = r % 584, j = nb * 32 + nl;
            const float* base = a.in[I_WIN] + (size_t)l * DM * NIN;
            const float* sp = j < 10240 ? base + j : (j < 18432 ? base + j + 16 : (j < 18448 ? base + (j - 8192) : nullptr));
            tr_item(sp, NIN, kb * 64, (bf16_t*)(wl + WO_WIN), DM, nb * 32, scr, lane); continue; }
        r -= C0;
        if (r < C1) { const int kb = r / 320, nb = r % 320, j = nb * 32 + nl; const float* sp;
            if (j < 2048) sp = a.in[I_WCO] + (size_t)l * 1024 * DM + j;
            else if (j < 4096) sp = a.in[I_WSB] + (size_t)l * 1024 * DM + (j - 2048);
            else if (j < 6144) sp = a.in[I_WGLA] + (size_t)l * 1024 * DM + (j - 4096);
            else { const int rr = j - 6144, tile = rr >> 8, w = rr & 255; sp = (w < 128 ? a.in[I_WS5V] : a.in[I_WS5G]) + (size_t)l * 1024 * DM + tile * 128 + (w & 127); }
            tr_item(sp, DM, kb * 64, (bf16_t*)(wl + WO_WBR), 1024, nb * 32, scr, lane); continue; }
        r -= C1;
        if (r < C2) { const int kb = r / 64, nb = r % 64, j = nb * 32 + nl;
            tr_item(a.in[I_WO] + (size_t)l * DM * DM + j, DM, kb * 64, (bf16_t*)(wl + WO_WO), DM, nb * 32, scr, lane); continue; }
        r -= C2;
        if (r < C3) { const int kb = r / 352, nb = r % 352, j = nb * 32 + nl; const int tile = j >> 8, w = j & 255;
            const float* sp = (w < 128 ? a.in[I_FFG] : a.in[I_FFU]) + (size_t)l * DM * DFF + tile * 128 + (w & 127);
            tr_item(sp, DFF, kb * 64, (bf16_t*)(wl + WO_WGU), DM, nb * 32, scr, lane); continue; }
        r -= C3;
        { const int kb = r / 64, nb = r % 64, j = nb * 32 + nl;
            tr_item(a.in[I_FFD] + (size_t)l * DFF * DM + j, DM, kb * 64, (bf16_t*)(wl + WO_WD), DFF, nb * 32, scr, lane); }
    }
}

__device__ __forceinline__ void p0_adaln_item(const Args& a, unsigned char* smem, int item, int tid) {
    const int lane = tid & 63, w = tid >> 6;
    float* sc = (float*)smem;
    float* red = (float*)(smem + 32768);
    const int l = item / 192, col0 = (item % 192) * 64;
    const float* wp = a.in[I_ADAW] + (size_t)l * DM * 12288 + col0 + lane;
    float acc0 = 0.f, acc1 = 0.f, acc2 = 0.f, acc3 = 0.f;
    const int k0 = w * 256;
#pragma unroll 8
    for (int k = k0; k < k0 + 256; ++k) { const float wv = wp[(size_t)k * 12288];
        acc0 += sc[k] * wv; acc1 += sc[2048 + k] * wv; acc2 += sc[4096 + k] * wv; acc3 += sc[6144 + k] * wv; }
    red[(w * 4 + 0) * 64 + lane] = acc0; red[(w * 4 + 1) * 64 + lane] = acc1; red[(w * 4 + 2) * 64 + lane] = acc2; red[(w * 4 + 3) * 64 + lane] = acc3;
    __syncthreads();
    if (tid < 256) { const int b = tid >> 6, col = tid & 63; float s = a.in[I_ADAB][l * 12288 + col0 + col];
#pragma unroll
        for (int ww = 0; ww < 8; ++ww) s += red[(ww * 4 + b) * 64 + col];
        ((float*)(a.ws + WS_MOD))[(size_t)(l * 4 + b) * 12288 + col0 + col] = s; }
    __syncthreads();
}

__device__ __forceinline__ void p0_s5pre_item(const Args& a, unsigned char* smem, int item, int tid) {
    const int l = item >> 6, g = item & 63, lg = l * 64 + g;
    float2* Bb = (float2*)(smem + 40960);
    float2* Cc = Bb + 1024;
    float2* Pw = Cc + 1024;
    float* Kt = (float*)(Pw + 17 * 64);
    float2* Ff = (float2*)(Kt + 4096);
    unsigned char* s5w = a.ws + WS_S5M + (size_t)l * S5_LAYER;
    if (tid < 64) { const int p = tid;
        const double dt = exp((double)a.in[I_LOGDT][lg]);
        const double lr = (double)a.in[I_LRE][lg * 64 + p], li = (double)a.in[I_LIM][lg * 64 + p];
        const double rev = li * dt * 0.15915494309189535;
        double abr = 0.0, abi = 0.0;
        for (int tau = 0; tau <= 16; ++tau) { const double mg = exp(lr * dt * tau); double x = rev * tau; x -= rint(x);
            const double s = sinpi(2.0 * x), c = cospi(2.0 * x);
            Pw[tau * 64 + p] = make_float2((float)(mg * c), (float)(mg * s));
            if (tau == 1) { abr = mg * c; abi = mg * s; } }
        const double den = lr * lr + li * li, nr = abr - 1.0, ni = abi;
        Ff[p] = make_float2((float)((nr * lr + ni * li) / den), (float)((ni * lr - nr * li) / den));
        ((float2*)(s5w + S5O_A16))[g * 64 + p] = Pw[16 * 64 + p];
    }
    __syncthreads();
    for (int e = tid; e < 1024; e += 512) { const int p = e >> 4;
        const float br = a.in[I_BRE][(size_t)lg * 1024 + e], bi = a.in[I_BIM][(size_t)lg * 1024 + e]; const float2 f = Ff[p];
        Bb[e] = make_float2(f.x * br - f.y * bi, f.x * bi + f.y * br);
        Cc[e] = make_float2(a.in[I_CRE][(size_t)lg * 1024 + e], a.in[I_CIM][(size_t)lg * 1024 + e]); }
    __syncthreads();
    for (int idx = tid; idx < 4096; idx += 512) { const int tau = idx >> 8, h = (idx >> 4) & 15, hp = idx & 15; float s = 0.f;
        for (int p = 0; p < 64; ++p) { const float2 c = Cc[h * 64 + p], w = Pw[tau * 64 + p], b = Bb[p * 16 + hp];
            const float cr = c.x * w.x - c.y * w.y, ci = c.x * w.y + c.y * w.x; s += cr * b.x - ci * b.y; }
        Kt[idx] = s; }
    __syncthreads();
    {
        bf16_t* MR = (bf16_t*)(s5w + S5O_MROW) + (size_t)g * 256 * 384;
        for (int e2 = tid; e2 < 256 * 192; e2 += 512) { const int n = e2 / 192, k2 = (e2 % 192) * 2; const int i = n >> 4, h = n & 15; float v[2];
#pragma unroll
            for (int u = 0; u < 2; ++u) { const int k = k2 + u;
                if (k < 256) { const int j = k >> 4, hp = k & 15; v[u] = (i >= j) ? Kt[(i - j) * 256 + h * 16 + hp] : 0.f; }
                else if (k < 320) { const int p = k - 256; const float2 c = Cc[h * 64 + p], w = Pw[(i + 1) * 64 + p]; v[u] = c.x * w.x - c.y * w.y; }
                else { const int p = k - 320; const float2 c = Cc[h * 64 + p], w = Pw[(i + 1) * 64 + p]; v[u] = -(c.x * w.y + c.y * w.x); } }
            *(unsigned*)(MR + (size_t)n * 384 + k2) = pk2(v[0], v[1]); }
        bf16_t* MI = (bf16_t*)(s5w + S5O_MIN) + (size_t)g * 128 * 256;
        for (int e2 = tid; e2 < 128 * 128; e2 += 512) { const int n2 = e2 >> 7, k2 = (e2 & 127) * 2; const int p = n2 & 63; float v[2];
#pragma unroll
            for (int u = 0; u < 2; ++u) { const int k = k2 + u, j = k >> 4, hp = k & 15; const float2 w = Pw[(15 - j) * 64 + p], b = Bb[p * 16 + hp];
                v[u] = (n2 < 64) ? (w.x * b.x - w.y * b.y) : (w.x * b.y + w.y * b.x); }
            *(unsigned*)(MI + (size_t)n2 * 256 + k2) = pk2(v[0], v[1]); }
    }
    __syncthreads();
}

__device__ __forceinline__ void ln_stats(const f32x4 (&v)[8], float& mean, float& rstd) {
    float s = 0.f;
#pragma unroll
    for (int j = 0; j < 8; ++j) s += (v[j][0] + v[j][1]) + (v[j][2] + v[j][3]);
    mean = wave_sum(s) * (1.f / DM); float q = 0.f;
#pragma unroll
    for (int j = 0; j < 8; ++j) { const f32x4 d = v[j] - mean; q += (d[0] * d[0] + d[1] * d[1]) + (d[2] * d[2] + d[3] * d[3]); }
    rstd = rsqrtf(wave_sum(q) * (1.f / DM) + 1e-5f);
}
__device__ __forceinline__ void ln_mod_store(const f32x4 (&v)[8], const float* sc, const float* sh, bf16_t* hrow, int lane) {
    float mean, rstd; ln_stats(v, mean, rstd);
#pragma unroll
    for (int j = 0; j < 8; ++j) { const int c = 4 * lane + 256 * j; const f32x4 s = *(const f32x4*)(sc + c), t = *(const f32x4*)(sh + c);
        const f32x4 y = (v[j] - mean) * rstd * (s + 1.f) + t; u32x2 w; w.x = pk2(y[0], y[1]); w.y = pk2(y[2], y[3]); *(u32x2*)(hrow + c) = w; }
}
__device__ __forceinline__ void ln_phase(const float* in, const float* g, const float* bta, float* xo, const float* modsc, const float* modsh, bf16_t* H, int gw, int ngw, int lane) {
    for (int m = gw; m < MTOK; m += ngw) {
        f32x4 v[8];
#pragma unroll
        for (int j = 0; j < 8; ++j) v[j] = *(const f32x4*)(in + (size_t)m * DM + 4 * lane + 256 * j);
        if (g) { float mean, rstd; ln_stats(v, mean, rstd);
#pragma unroll
            for (int j = 0; j < 8; ++j) { const int c = 4 * lane + 256 * j; const f32x4 gg = *(const f32x4*)(g + c), bb = *(const f32x4*)(bta + c);
                v[j] = (v[j] - mean) * rstd * gg + bb; *(f32x4*)(xo + (size_t)m * DM + c) = v[j]; } }
        if (modsc) { const int b = m >> 11; ln_mod_store(v, modsc + (size_t)b * 12288, modsh + (size_t)b * 12288, H + (size_t)m * DM, lane); }
    }
}

__device__ __forceinline__ void conv_item(const bf16_t* P, bf16_t* BR, const float* cw, int it, int tid) {
    const int idx = it * 512 + tid, m = idx >> 7, c8 = (idx & 127) * 8, t = m & (SEQ - 1);
    const bf16_t* pr = P + (size_t)m * NPROJ;
    float accv[8];
#pragma unroll
    for (int i = 0; i < 8; ++i) accv[i] = 0.f;
#pragma unroll
    for (int j = 0; j < 3; ++j) { const int dtk = 2 - j; if (t - dtk < 0) continue;
        const bf16_t* pj = pr - (size_t)dtk * NPROJ;
        const u32x4 cc = *(const u32x4*)(pj + C_CVC + c8), xx = *(const u32x4*)(pj + C_CVX + c8);
        const f32x4 w0 = *(const f32x4*)(cw + j * 1024 + c8), w1 = *(const f32x4*)(cw + j * 1024 + c8 + 4);
        accv[0] += w0[0] * lo16(cc.x) * lo16(xx.x); accv[1] += w0[1] * hi16(cc.x) * hi16(xx.x);
        accv[2] += w0[2] * lo16(cc.y) * lo16(xx.y); accv[3] += w0[3] * hi16(cc.y) * hi16(xx.y);
        accv[4] += w1[0] * lo16(cc.z) * lo16(xx.z); accv[5] += w1[1] * hi16(cc.z) * hi16(xx.z);
        accv[6] += w1[2] * lo16(cc.w) * lo16(xx.w); accv[7] += w1[3] * hi16(cc.w) * hi16(xx.w); }
    const u32x4 bb = *(const u32x4*)(pr + C_CVB + c8);
    u32x4 o; o.x = pk2(accv[0] * lo16(bb.x), accv[1] * hi16(bb.x)); o.y = pk2(accv[2] * lo16(bb.y), accv[3] * hi16(bb.y));
    o.z = pk2(accv[4] * lo16(bb.z), accv[5] * hi16(bb.z)); o.w = pk2(accv[6] * lo16(bb.w), accv[7] * hi16(bb.w));
    *(u32x4*)(BR + (size_t)m * NBR + BR_CONV + c8) = o;
}

__device__ __forceinline__ void s5a_item(const bf16_t* P, const bf16_t* MIN, float* SLOC, int wi, int lane) {
    const int g = wi >> 5, ct = wi & 31, c16 = lane & 15, q = lane >> 4;
    const int cc = ct * 16 + c16, b = cc >> 7, c = cc & 127;
    bf16x8 bf[8];
#pragma unroll
    for (int ks = 0; ks < 8; ++ks) bf[ks] = *(const bf16x8*)(P + (size_t)(b * SEQ + c * 16 + 2 * ks + (q >> 1)) * NPROJ + C_S5U + g * 16 + (q & 1) * 8);
    const bf16_t* Mg = MIN + (size_t)g * 128 * 256;
    float* out = SLOC + ((size_t)(b * 128 + c) * 64 + g) * 128;
#pragma unroll
    for (int rt = 0; rt < 8; ++rt) { f32x4 acc = {0.f, 0.f, 0.f, 0.f};
#pragma unroll
        for (int ks = 0; ks < 8; ++ks) { const bf16x8 af = *(const bf16x8*)(Mg + (size_t)(16 * rt + c16) * 256 + 32 * ks + 8 * q); acc = MFMA16(af, bf[ks], acc); }
        *(f32x4*)(out + 16 * rt + 4 * q) = acc; }
}

__device__ __forceinline__ void s5c_item(const bf16_t* P, const bf16_t* MROW, const bf16_t* SPREV, const float* dsk, bf16_t* BR, int wi, int lane) {
    const int g = wi >> 5, ct = wi & 31, c16 = lane & 15, q = lane >> 4;
    const int cc = ct * 16 + c16, b = cc >> 7, c = cc & 127;
    bf16x8 bf[12];
#pragma unroll
    for (int ks = 0; ks < 8; ++ks) bf[ks] = *(const bf16x8*)(P + (size_t)(b * SEQ + c * 16 + 2 * ks + (q >> 1)) * NPROJ + C_S5U + g * 16 + (q & 1) * 8);
    const bf16_t* sp = SPREV + ((size_t)(b * 128 + c) * 64 + g) * 128;
#pragma unroll
    for (int ks = 0; ks < 4; ++ks) bf[8 + ks] = *(const bf16x8*)(sp + 32 * ks + 8 * q);
    const bf16_t* Mg = MROW + (size_t)g * 256 * 384;
    const f32x4 dv = *(const f32x4*)(dsk + g * 16 + 4 * q);
#pragma unroll
    for (int i = 0; i < 16; ++i) { f32x4 acc = {0.f, 0.f, 0.f, 0.f};
        const bf16_t* mrow = Mg + (size_t)(16 * i + c16) * 384 + 8 * q;
#pragma unroll
        for (int ks = 0; ks < 8; ++ks) if (ks <= (i >> 1)) { const bf16x8 af = *(const bf16x8*)(mrow + 32 * ks); acc = MFMA16(af, bf[ks], acc); }
#pragma unroll
        for (int ks = 8; ks < 12; ++ks) { const bf16x8 af = *(const bf16x8*)(mrow + 32 * ks); acc = MFMA16(af, bf[ks], acc); }
        const size_t m = (size_t)b * SEQ + c * 16 + i;
        const u32x2 uw = *(const u32x2*)(P + m * NPROJ + C_S5U + g * 16 + 4 * q);
        const float y0 = acc[0] + dv[0] * lo16(uw.x), y1 = acc[1] + dv[1] * hi16(uw.x), y2 = acc[2] + dv[2] * lo16(uw.y), y3 = acc[3] + dv[3] * hi16(uw.y);
        u32x2 o; o.x = pk2(gelu_tanh(y0), gelu_tanh(y1)); o.y = pk2(gelu_tanh(y2), gelu_tanh(y3));
        *(u32x2*)(BR + m * NBR + BR_S5 + g * 16 + 4 * q) = o; }
}

__device__ __forceinline__ void stage_vt64(const bf16_t* P, size_t m0, int vcol0, bf16_t* VT, int tid) {
#pragma unroll
    for (int i = 0; i < 4; ++i) { const int id = tid + 512 * i, t = id >> 5, v8 = (id & 31) * 8;
        const u32x4 vv = *(const u32x4*)(P + (m0 + t) * NPROJ + vcol0 + v8);
        VT[(v8 + 0) * 72 + t] = (bf16_t)(vv.x & 0xffffu); VT[(v8 + 1) * 72 + t] = (bf16_t)(vv.x >> 16);
        VT[(v8 + 2) * 72 + t] = (bf16_t)(vv.y & 0xffffu); VT[(v8 + 3) * 72 + t] = (bf16_t)(vv.y >> 16);
        VT[(v8 + 4) * 72 + t] = (bf16_t)(vv.z & 0xffffu); VT[(v8 + 5) * 72 + t] = (bf16_t)(vv.z >> 16);
        VT[(v8 + 6) * 72 + t] = (bf16_t)(vv.w & 0xffffu); VT[(v8 + 7) * 72 + t] = (bf16_t)(vv.w >> 16); }
}

__device__ __forceinline__ void glaa_item(const bf16_t* P, const float* wgate, const float* bgate, float* BCUM, float* AEND, float* LCT, unsigned char* smem, int it, int tid) {
    const int bh = it >> 5, cn = it & 31, b = bh >> 2, h = bh & 3; const size_t m0 = (size_t)b * SEQ + cn * 64;
    const int lane = tid & 63, w = tid >> 6, c16 = lane & 15, q = lane >> 4;
    float* lrs = (float*)smem;
    float* part = (float*)(smem + 4096);
    bf16_t* KdT = (bf16_t*)(smem + 8192);
    bf16_t* VT = (bf16_t*)(smem + 8192 + 18432);
    if (tid < 128) { const int t = tid >> 1, hf = tid & 1; const u32x4 v = *(const u32x4*)(P + (m0 + t) * NPROJ + C_GLLR + hf * 8);
        float* d = lrs + t * 16 + hf * 8; d[0] = lo16(v.x); d[1] = hi16(v.x); d[2] = lo16(v.y); d[3] = hi16(v.y); d[4] = lo16(v.z); d[5] = hi16(v.z); d[6] = lo16(v.w); d[7] = hi16(v.w); }
    stage_vt64(P, m0, C_GLV + h * 256, VT, tid);
    __syncthreads();
    const int k = tid & 127, tg = tid >> 7;
    float wg[16];
#pragma unroll
    for (int r = 0; r < 16; ++r) wg[r] = wgate[r * 512 + h * 128 + k];
    const float bias = bgate[h * 128 + k];
    float bl[16]; float run = 0.f;
#pragma unroll
    for (int tt = 0; tt < 16; ++tt) { const float* lr = lrs + (16 * tg + tt) * 16; float z = bias;
#pragma unroll
        for (int r = 0; r < 16; ++r) z += lr[r] * wg[r];
        const float la = (fminf(z, 0.f) - __logf(1.f + __expf(-fabsf(z)))) * (1.f / 16.f);
        run += la; bl[tt] = run; }
    part[tg * 128 + k] = run;
    __syncthreads();
    float off = 0.f, bend = 0.f;
#pragma unroll
    for (int g2 = 0; g2 < 4; ++g2) { const float pv = part[g2 * 128 + k]; bend += pv; if (g2 < tg) off += pv; }
    if (tg == 0) AEND[(size_t)(bh * 32 + cn) * 128 + k] = __expf(bend);
    unsigned kd[8];
#pragma unroll
    for (int tt = 0; tt < 16; tt += 2) {
        const float b0 = bl[tt] + off, b1 = bl[tt + 1] + off; const size_t t0 = m0 + 16 * tg + tt;
        BCUM[t0 * 512 + h * 128 + k] = b0; BCUM[(t0 + 1) * 512 + h * 128 + k] = b1;
        const float k0v = bf2f(P[t0 * NPROJ + C_GLK + h * 128 + k]), k1v = bf2f(P[(t0 + 1) * NPROJ + C_GLK + h * 128 + k]);
        kd[tt >> 1] = pk2(k0v * __expf(bend - b0), k1v * __expf(bend - b1)); }
    { u32x4 w0, w1; w0.x = kd[0]; w0.y = kd[1]; w0.z = kd[2]; w0.w = kd[3]; w1.x = kd[4]; w1.y = kd[5]; w1.z = kd[6]; w1.w = kd[7];
      *(u32x4*)(KdT + k * 72 + 16 * tg) = w0; *(u32x4*)(KdT + k * 72 + 16 * tg + 8) = w1; }
    __syncthreads();
    float* out = LCT + (size_t)(bh * 32 + cn) * 32768;
#pragma unroll
    for (int vi = 0; vi < 2; ++vi) { const int vt = 2 * w + vi;
        const bf16x8 a0 = *(const bf16x8*)(VT + (16 * vt + c16) * 72 + 8 * q), a1 = *(const bf16x8*)(VT + (16 * vt + c16) * 72 + 32 + 8 * q);
#pragma unroll
        for (int kt = 0; kt < 8; ++kt) { f32x4 acc = {0.f, 0.f, 0.f, 0.f};
            const bf16x8 b0 = *(const bf16x8*)(KdT + (16 * kt + c16) * 72 + 8 * q), b1 = *(const bf16x8*)(KdT + (16 * kt + c16) * 72 + 32 + 8 * q);
            acc = MFMA16(a0, b0, acc); acc = MFMA16(a1, b1, acc);
#pragma unroll
            for (int j = 0; j < 4; ++j) out[(size_t)(16 * vt + 4 * q + j) * 128 + 16 * kt + c16] = acc[j]; } }
    __syncthreads();
}

__device__ __forceinline__ void glac_item(const bf16_t* P, const float* BCUM, const bf16_t* SNT, const float* gn, bf16_t* BR, unsigned char* smem, int it, int tid) {
    const int bh = it >> 5, cn = it & 31, b = bh >> 2, h = bh & 3; const size_t m0 = (size_t)b * SEQ + cn * 64;
    const int lane = tid & 63, w = tid >> 6, c16 = lane & 15, q = lane >> 4;
    bf16_t* Qd = (bf16_t*)smem;
    bf16_t* Ki = (bf16_t*)(smem + 17408);
    bf16_t* Pm = (bf16_t*)(smem + 34816);
    bf16_t* VT = (bf16_t*)(smem + 44032);
    float* st = (float*)(smem + 44032 + 36864);
    stage_vt64(P, m0, C_GLV + h * 256, VT, tid);
    { const int k = tid & 127, tg = tid >> 7;
#pragma unroll 4
      for (int tt = 0; tt < 16; ++tt) { const int t = 16 * tg + tt; const size_t m = m0 + t;
          const float bv = BCUM[m * 512 + h * 128 + k];
          const float qv = bf2f(P[m * NPROJ + C_GLQ + h * 128 + k]), kv = bf2f(P[m * NPROJ + C_GLK + h * 128 + k]);
          Qd[t * 136 + k] = (bf16_t)f2bf(qv * QSCALE * __expf(bv)); Ki[t * 136 + k] = (bf16_t)f2bf(kv * __expf(-bv)); } }
    __syncthreads();
#pragma unroll
    for (int ti = 0; ti < 2; ++ti) { const int tile = 2 * w + ti, tt = tile >> 2, stl = tile & 3; f32x4 acc = {0.f, 0.f, 0.f, 0.f};
        if (stl <= tt) {
#pragma unroll
            for (int ks = 0; ks < 4; ++ks) { const bf16x8 af = *(const bf16x8*)(Qd + (16 * tt + c16) * 136 + 32 * ks + 8 * q), bfr = *(const bf16x8*)(Ki + (16 * stl + c16) * 136 + 32 * ks + 8 * q);
                acc = MFMA16(af, bfr, acc); } }
#pragma unroll
        for (int j = 0; j < 4; ++j) { const int t = 16 * tt + 4 * q + j, s = 16 * stl + c16; Pm[t * 72 + s] = (bf16_t)f2bf((s <= t) ? acc[j] : 0.f); } }
    __syncthreads();
    {
        const int tt = w & 3, vt0 = 8 * (w >> 2);
        bf16x8 pa[2], qa[4];
#pragma unroll
        for (int ks = 0; ks < 2; ++ks) pa[ks] = *(const bf16x8*)(Pm + (16 * tt + c16) * 72 + 32 * ks + 8 * q);
#pragma unroll
        for (int ks = 0; ks < 4; ++ks) qa[ks] = *(const bf16x8*)(Qd + (16 * tt + c16) * 136 + 32 * ks + 8 * q);
        const bf16_t* Sg = SNT + (size_t)(bh * 32 + cn) * 32768;
        f32x4 o[8];
#pragma unroll
        for (int vi = 0; vi < 8; ++vi) { const int vt = vt0 + vi; f32x4 acc = {0.f, 0.f, 0.f, 0.f};
#pragma unroll
            for (int ks = 0; ks < 2; ++ks) { const bf16x8 bfr = *(const bf16x8*)(VT + (16 * vt + c16) * 72 + 32 * ks + 8 * q); acc = MFMA16(pa[ks], bfr, acc); }
#pragma unroll
            for (int ks = 0; ks < 4; ++ks) { const bf16x8 bfr = *(const bf16x8*)(Sg + (size_t)(16 * vt + c16) * 128 + 32 * ks + 8 * q); acc = MFMA16(qa[ks], bfr, acc); }
            o[vi] = acc; }
        float s1[4], s2[4];
#pragma unroll
        for (int j = 0; j < 4; ++j) { float a1 = 0.f, a2 = 0.f;
#pragma unroll
            for (int vi = 0; vi < 8; ++vi) { a1 += o[vi][j]; a2 += o[vi][j] * o[vi][j]; }
#pragma unroll
            for (int x = 1; x < 16; x <<= 1) { a1 += __shfl_xor(a1, x); a2 += __shfl_xor(a2, x); }
            s1[j] = a1; s2[j] = a2; }
        if (c16 == 0) {
#pragma unroll
            for (int j = 0; j < 4; ++j) { st[((w >> 2) * 64 + 16 * tt + 4 * q + j) * 2] = s1[j]; st[((w >> 2) * 64 + 16 * tt + 4 * q + j) * 2 + 1] = s2[j]; } }
        __syncthreads();
#pragma unroll
        for (int j = 0; j < 4; ++j) { const int t = 16 * tt + 4 * q + j;
            const float a1 = st[t * 2] + st[(64 + t) * 2], a2 = st[t * 2 + 1] + st[(64 + t) * 2 + 1];
            const float mean = a1 * (1.f / 256.f), var = a2 * (1.f / 256.f) - mean * mean, rstd = rsqrtf(var + 1e-5f);
            const size_t m = m0 + t;
#pragma unroll
            for (int vi = 0; vi < 8; ++vi) { const int v = 16 * (vt0 + vi) + c16;
                const float r = bf2f(P[m * NPROJ + C_GLR + h * 256 + v]);
                BR[m * NBR + BR_GLA + h * 256 + v] = (bf16_t)f2bf((o[vi][j] - mean) * rstd * gn[h * 256 + v] * siluf_(r)); } }
    }
    __syncthreads();
}

__device__ __forceinline__ void attn_unit(const bf16_t* P, bf16_t* BR, unsigned char* smem, int unit, int tid) {
    const int lane = tid & 63, w = tid >> 6, c16 = lane & 15, q = lane >> 4;
    bf16_t* Ks = (bf16_t*)smem;
    bf16_t* VT = (bf16_t*)(smem + 8704);
    const int bh = unit >> 3, pr = unit & 7, b = bh >> 3, h = bh & 7;
    for (int half = 0; half < 2; ++half) {
        const int qb = half ? 15 - pr : pr;
        const int tq = qb * 128 + 16 * w + c16;
        const size_t mq = (size_t)b * SEQ + tq;
        bf16x8 qf[4];
#pragma unroll
        for (int ks = 0; ks < 4; ++ks) qf[ks] = *(const bf16x8*)(P + mq * NPROJ + C_SBQ + h * 128 + 32 * ks + 8 * q);
        f32x4 o[8];
#pragma unroll
        for (int d = 0; d < 8; ++d) o[d] = (f32x4){0.f, 0.f, 0.f, 0.f};
        float R = 0.f;
        for (int kt = qb * 4 + 3; kt >= 0; --kt) {
            const int key0 = kt * 32;
            __syncthreads();
            { const int key = tid >> 4, d8 = (tid & 15) * 8; const size_t mk = (size_t)b * SEQ + key0 + key;
              const u32x4 kv = *(const u32x4*)(P + mk * NPROJ + C_SBK + h * 128 + d8);
              const u32x4 vv = *(const u32x4*)(P + mk * NPROJ + C_SBV + h * 128 + d8);
              *(u32x4*)(Ks + key * 136 + d8) = kv;
              VT[(d8 + 0) * 40 + key] = (bf16_t)(vv.x & 0xffffu); VT[(d8 + 1) * 40 + key] = (bf16_t)(vv.x >> 16);
              VT[(d8 + 2) * 40 + key] = (bf16_t)(vv.y & 0xffffu); VT[(d8 + 3) * 40 + key] = (bf16_t)(vv.y >> 16);
              VT[(d8 + 4) * 40 + key] = (bf16_t)(vv.z & 0xffffu); VT[(d8 + 5) * 40 + key] = (bf16_t)(vv.z >> 16);
              VT[(d8 + 6) * 40 + key] = (bf16_t)(vv.w & 0xffffu); VT[(d8 + 7) * 40 + key] = (bf16_t)(vv.w >> 16); }
            __syncthreads();
            if (key0 > qb * 128 + 16 * w + 15) continue;
            f32x4 s0 = {0.f, 0.f, 0.f, 0.f}, s1 = {0.f, 0.f, 0.f, 0.f};
#pragma unroll
            for (int ks = 0; ks < 4; ++ks) { const bf16x8 a0 = *(const bf16x8*)(Ks + c16 * 136 + 32 * ks + 8 * q), a1 = *(const bf16x8*)(Ks + (16 + c16) * 136 + 32 * ks + 8 * q);
                s0 = MFMA16(a0, qf[ks], s0); s1 = MFMA16(a1, qf[ks], s1); }
            float z0[4], z1[4], c0[4], c1[4]; bool v0[4], v1[4];
#pragma unroll
            for (int j = 0; j < 4; ++j) { const int sp = key0 + 4 * q + j; z0[j] = s0[j] * QSCALE; z1[j] = s1[j] * QSCALE; v0[j] = sp < tq; v1[j] = (sp + 16) < tq;
                c0[j] = v0[j] ? softplusf_(z0[j]) : 0.f; c1[j] = v1[j] ? softplusf_(z1[j]) : 0.f; }
            c0[2] += c0[3]; c0[1] += c0[2]; c0[0] += c0[1]; c1[2] += c1[3]; c1[1] += c1[2]; c1[0] += c1[1];
            const float T0 = c0[0], T1 = c1[0];
            const float a0x = __shfl_xor(T0, 16), b0x = T0 + a0x, cc0 = __shfl_xor(b0x, 32);
            const float a1x = __shfl_xor(T1, 16), b1x = T1 + a1x, cc1 = __shfl_xor(b1x, 32);
            const float after0 = ((q & 1) ? 0.f : a0x) + ((q & 2) ? 0.f : cc0), after1 = ((q & 1) ? 0.f : a1x) + ((q & 2) ? 0.f : cc1);
            const float all0 = b0x + cc0, all1 = b1x + cc1;
            const float base1 = R + after1, base0 = R + all1 + after0;
            float w0[4], w1[4];
#pragma unroll
            for (int j = 0; j < 4; ++j) { w0[j] = v0[j] ? __expf(z0[j] - (c0[j] + base0)) : 0.f; w1[j] = v1[j] ? __expf(z1[j] - (c1[j] + base1)) : 0.f; }
            R += all0 + all1;
            union { bf16x8 v; unsigned u[4]; } wf;
            wf.u[0] = pk2(w0[0], w0[1]); wf.u[1] = pk2(w0[2], w0[3]); wf.u[2] = pk2(w1[0], w1[1]); wf.u[3] = pk2(w1[2], w1[3]);
#pragma unroll
            for (int dt = 0; dt < 8; ++dt) { const int d = 16 * dt + c16;
                union { bf16x8 v; s16x4 hlf[2]; } af;
                af.hlf[0] = *(const s16x4*)(VT + d * 40 + 4 * q); af.hlf[1] = *(const s16x4*)(VT + d * 40 + 16 + 4 * q);
                o[dt] = MFMA16(af.v, wf.v, o[dt]); }
        }
#pragma unroll
        for (int dt = 0; dt < 8; ++dt) { u32x2 ov; ov.x = pk2(o[dt][0], o[dt][1]); ov.y = pk2(o[dt][2], o[dt][3]);
            *(u32x2*)(BR + mq * NBR + BR_SB + h * 128 + 16 * dt + 4 * q) = ov; }
    }
    __syncthreads();
}

constexpr int NPH = 23;
__global__ void __launch_bounds__(512, 2) mk_fwd(Args a) {
    extern __shared__ __attribute__((aligned(16))) unsigned char smem[];
    cg::grid_group grid = cg::this_grid();
    int tid = threadIdx.x, lane = tid & 63, wave = __builtin_amdgcn_readfirstlane(tid >> 6);
    int G = gridDim.x, bid = blockIdx.x, gw = bid * 8 + wave, ngw = G * 8;
    LAS unsigned char* lds = (LAS unsigned char*)smem;
    unsigned char* ws = a.ws;
    float* MOD = (float*)(ws + WS_MOD);
    bf16_t* H = (bf16_t*)(ws + WS_H); bf16_t* PROJ = (bf16_t*)(ws + WS_PROJ); bf16_t* ACT = (bf16_t*)(ws + WS_ACT);
    bf16_t* BR = (bf16_t*)(ws + WS_BR); float* Y = (float*)(ws + WS_Y); bf16_t* MBF = (bf16_t*)(ws + WS_MB); float* X1 = (float*)(ws + WS_X1);
    float* SLOC = (float*)(ws + WS_SLOC); bf16_t* SPREV = (bf16_t*)(ws + WS_SPREV); float* BCUM = (float*)(ws + WS_BCUM);
    float* AEND = (float*)(ws + WS_AEND); float* LCT = (float*)(ws + WS_LCT); bf16_t* SNT = (bf16_t*)(ws + WS_SNT);
    const int lo = a.ph_lo, hi = a.ph_hi;
#define IN(k) (lo <= (k) && (k) < hi)
#define SEAM(k) do { if (IN(k) && IN((k) + 1)) grid.sync(); FRESH(); } while (0)
#define FRESH() do { tid = threadIdx.x; asm volatile("" : "+v"(tid)); lane = tid & 63; wave = __builtin_amdgcn_readfirstlane(tid >> 6); bid = blockIdx.x; asm volatile("" : "+s"(bid)); G = gridDim.x; asm volatile("" : "+s"(G)); gw = bid * 8 + wave; ngw = G * 8; } while (0)

    if (IN(0)) {
        {
            float* sc = (float*)smem;
            for (int i = tid; i < NB * DM; i += 512) sc[i] = siluf_(a.in[I_C][i]);
            __syncthreads();
            for (int it = bid; it < 384; it += G) p0_adaln_item(a, smem, it, tid);
            __syncthreads();
        }
        for (int it = bid; it < 128; it += G) p0_s5pre_item(a, smem, it, tid);
        __syncthreads();
        p0_transposes(a, smem, gw, ngw, wave, lane);
        __syncthreads();
    }
    SEAM(0);

    for (int l = 0; l < 2; ++l) {
        const int pb = 1 + 11 * l;
        const unsigned char* wl = ws + WS_W + (size_t)l * W_LAYER;
        const unsigned char* s5w = ws + WS_S5M + (size_t)l * S5_LAYER;
        const float* modl = MOD + (size_t)l * 4 * 12288;
        const float* xin = l == 0 ? a.in[I_X] : a.out;
        if (IN(pb + 0) && l == 0) ln_phase(xin, nullptr, nullptr, nullptr, modl + 2048, modl, H, gw, ngw, lane);
        if (l == 0) SEAM(pb + 0);
        if (IN(pb + 1)) { pg8::Gemm g{H, (const bf16_t*)(wl + WO_WIN), DM, DM, DM}; pg8::StaticOrder S; S.init(MTOK, NPROJ, G, bid);
            pg8::EpiBf16 E{PROJ, NPROJ}; pg8::gemm_phase(lds, g, S, E, tid); }
        SEAM(pb + 1);
        if (IN(pb + 2)) {
            for (int u = bid; u < 256; u += G) attn_unit(PROJ, BR, smem, u, tid);
            for (int it = bid; it < 512; it += G) glaa_item(PROJ, a.in[I_GLAWG] + (size_t)l * 16 * 512, a.in[I_GLABG] + l * 512, BCUM, AEND, LCT, smem, it, tid);
            for (int it = gw; it < 2048; it += ngw) s5a_item(PROJ, (const bf16_t*)(s5w + S5O_MIN), SLOC, it, lane);
            for (int it = bid; it < 2048; it += G) conv_item(PROJ, BR, a.in[I_CONVW] + (size_t)l * 3 * 1024, it, tid);
        }
        SEAM(pb + 2);
        if (IN(pb + 3)) {
            for (int it = bid; it < 32 + 1024; it += G) {
                if (it < 32) { const int idx = it * 512 + tid, b = idx >> 12, g = (idx >> 6) & 63, p = idx & 63;
                    const float2 ab = ((const float2*)(s5w + S5O_A16))[g * 64 + p]; float sr = 0.f, si = 0.f;
#pragma unroll 4
                    for (int c = 0; c < 128; ++c) { const size_t base = ((size_t)(b * 128 + c) * 64 + g) * 128;
                        SPREV[base + p] = (bf16_t)f2bf(sr); SPREV[base + 64 + p] = (bf16_t)f2bf(si);
                        const float lr = SLOC[base + p], li = SLOC[base + 64 + p];
                        const float nr = ab.x * sr - ab.y * si + lr, ni = ab.x * si + ab.y * sr + li; sr = nr; si = ni; } }
                else { const int idx = (it - 32) * 512 + tid, bh = idx >> 15, e = idx & 32767, k = e & 127; float s = 0.f;
#pragma unroll 4
                    for (int cn = 0; cn < 32; ++cn) { const size_t base = (size_t)(bh * 32 + cn);
                        SNT[base * 32768 + e] = (bf16_t)f2bf(s);
                        s = AEND[base * 128 + k] * s + LCT[base * 32768 + e]; } }
            }
        }
        SEAM(pb + 3);
        if (IN(pb + 4)) {
            for (int it = bid; it < 512; it += G) glac_item(PROJ, BCUM, SNT, a.in[I_GLANG] + l * 1024, BR, smem, it, tid);
            for (int it = gw; it < 2048; it += ngw) s5c_item(PROJ, (const bf16_t*)(s5w + S5O_MROW), SPREV, a.in[I_S5D] + l * 1024, BR, it, lane);
        }
        SEAM(pb + 4);
        if (IN(pb + 5)) { pg8::Gemm g{BR, (const bf16_t*)(wl + WO_WBR), NBR, 1024, 1024}; pg8::BranchOrder S{G, bid};
            pg8::EpiBranch E{PROJ, Y, MBF}; pg8::gemm_phase(lds, g, S, E, tid); }
        SEAM(pb + 5);
        if (IN(pb + 6)) { pg8::Gemm g{MBF, (const bf16_t*)(wl + WO_WO), DM, DM, DM}; pg8::StaticOrder S; S.init(MTOK, DM, G, bid);
            pg8::EpiResid E{xin, modl + 2 * 2048, Y}; pg8::gemm_phase(lds, g, S, E, tid); }
        SEAM(pb + 6);
        if (IN(pb + 7)) ln_phase(Y, a.in[I_LN1G] + l * DM, a.in[I_LN1B] + l * DM, X1, modl + 4 * 2048, modl + 3 * 2048, H, gw, ngw, lane);
        SEAM(pb + 7);
        if (IN(pb + 8)) { pg8::Gemm g{H, (const bf16_t*)(wl + WO_WGU), DM, DM, DM}; pg8::StaticOrder S; S.init(MTOK, NGU, G, bid);
            pg8::EpiGateUp E{ACT}; pg8::gemm_phase(lds, g, S, E, tid); }
        SEAM(pb + 8);
        if (IN(pb + 9)) { pg8::Gemm g{ACT, (const bf16_t*)(wl + WO_WD), DFF, DFF, DFF}; pg8::StaticOrder S; S.init(MTOK, DM, G, bid);
            pg8::EpiResid E{X1, modl + 5 * 2048, Y}; pg8::gemm_phase(lds, g, S, E, tid); }
        SEAM(pb + 9);
        if (IN(pb + 10)) { const float* modn = MOD + (size_t)(l + 1) * 4 * 12288;
            ln_phase(Y, a.in[I_LN2G] + l * DM, a.in[I_LN2B] + l * DM, a.out, l == 0 ? modn + 2048 : nullptr, l == 0 ? modn : nullptr, H, gw, ngw, lane); }
        if (l == 0) SEAM(pb + 10);
    }
#undef IN
#undef SEAM
}

#ifndef MK_SPLIT
#define MK_SPLIT 0
#endif
extern "C" void kernel_launch(void* const* d_in, const int* in_sizes, int n_in, void* d_out, int out_size, void* d_ws, size_t ws_size, hipStream_t stream) {
    static int grid = 0;
    if (grid == 0) {
        if (n_in != 30 || ws_size < WS_END) { fprintf(stderr, "kernel_launch: unexpected n_in %d or ws_size %zu (< %zu)\n", n_in, ws_size, (size_t)WS_END); grid = -1; return; }
        int dev = 0, cus = 0, per_cu = 0;
        hipGetDevice(&dev); hipDeviceGetAttribute(&cus, hipDeviceAttributeMultiprocessorCount, dev);
        if (hipFuncSetAttribute((const void*)mk_fwd, hipFuncAttributeMaxDynamicSharedMemorySize, LDS_BYTES) != hipSuccess) { fprintf(stderr, "kernel_launch: hipFuncSetAttribute failed\n"); grid = -1; return; }
        if (hipOccupancyMaxActiveBlocksPerMultiprocessor(&per_cu, (const void*)mk_fwd, 512, LDS_BYTES) != hipSuccess || per_cu < 1) { fprintf(stderr, "kernel_launch: occupancy query says %d\n", per_cu); per_cu = 1; }
        (void)hipGetLastError();
        grid = cus > 256 ? 256 : cus;
    }
    if (grid < 0) return;
    Args a{};
    for (int i = 0; i < 30; ++i) a.in[i] = (const float*)d_in[i];
    a.out = (float*)d_out; a.ws = (unsigned char*)d_ws;
#if MK_SPLIT
    for (int ph = 0; ph < NPH; ++ph) { a.ph_lo = ph; a.ph_hi = ph + 1; hipLaunchKernelGGL(mk_fwd, dim3(grid), dim3(512), LDS_BYTES, stream, a); }
#else
    a.ph_lo = 0; a.ph_hi = NPH;
    void* args[] = {&a};
    hipError_t e = hipLaunchCooperativeKernel((const void*)mk_fwd, dim3(grid), dim3(512), args, LDS_BYTES, stream);
    if (e != hipSuccess) fprintf(stderr, "cooperative launch failed: %s (grid %d)\n", hipGetErrorString(e), grid);
#endif
}
```

```cpp
#include <hip/hip_runtime.h>
#include <hip/hip_cooperative_groups.h>
#include <cstdio>
#include <cstdint>
namespace cg = cooperative_groups;

#define LAS __attribute__((address_space(3)))
typedef unsigned short bf16_t;
typedef short bf16x8 __attribute__((ext_vector_type(8)));
typedef short s16x4 __attribute__((ext_vector_type(4)));
typedef float f32x4 __attribute__((ext_vector_type(4)));
typedef unsigned u32x4 __attribute__((ext_vector_type(4)));
typedef unsigned u32x2 __attribute__((ext_vector_type(2)));

constexpr int DM = 2048, NB = 4, SEQ = 2048, MTOK = NB * SEQ, NPROJ = 18688, NIN = 18448, DFF = 5632, NGU = 2 * DFF;
constexpr int C_CVB = 0, C_CVC = 1024, C_CVX = 2048, C_S5U = 3072, C_SBQ = 4096, C_SBK = 5120, C_SBV = 6144, C_GLQ = 7168,
              C_GLK = 7680, C_GLV = 8192, C_GLR = 9216, C_GCONV = 10240, C_GS5 = 12288, C_GSB = 14336, C_GGLA = 16384, C_GLLR = 18432;
constexpr int BR_CONV = 0, BR_S5 = 1024, BR_SB = 2048, BR_GLA = 3072, NBR = 4096;
constexpr float ALPHA = 1.41421356237f;
constexpr float QSCALE = 0.08838834764831845f;

constexpr size_t MiB = 1u << 20;
constexpr size_t W_LAYER = 167 * MiB;
constexpr size_t WO_WIN = 0, WO_WBR = 73 * MiB, WO_WO = 93 * MiB, WO_WGU = 101 * MiB, WO_WD = 145 * MiB;
constexpr size_t WS_W = 0;
constexpr size_t WS_S5M = 334 * MiB;
constexpr size_t S5_LAYER = 17 * MiB, S5O_MROW = 0, S5O_MIN = 12 * MiB, S5O_A16 = 16 * MiB;
constexpr size_t WS_MOD = 368 * MiB;
constexpr size_t WS_H = 369 * MiB;
constexpr size_t WS_PROJ = 401 * MiB;
constexpr size_t WS_ACT = WS_PROJ;
constexpr size_t WS_BR = 693 * MiB;
constexpr size_t WS_Y = 757 * MiB;
constexpr size_t WS_MB = 821 * MiB;
constexpr size_t WS_X1 = 853 * MiB;
constexpr size_t WS_SLOC = 917 * MiB;
constexpr size_t WS_SPREV = 933 * MiB;
constexpr size_t WS_BCUM = 941 * MiB;
constexpr size_t WS_AEND = 957 * MiB;
constexpr size_t WS_LCT = 958 * MiB;
constexpr size_t WS_SNT = 1022 * MiB;
constexpr size_t WS_CTL = 1054 * MiB;
constexpr size_t CTL_BYTES = 16384;
constexpr size_t WS_END = 1055 * MiB;

constexpr int LDS_BYTES = 147456;

__device__ __forceinline__ float bf2f(unsigned u) { return __builtin_bit_cast(float, u << 16); }
__device__ __forceinline__ unsigned f2bf(float f) { unsigned u = __builtin_bit_cast(unsigned, f); return (u + 0x7fffu + ((u >> 16) & 1u)) >> 16; }
__device__ __forceinline__ unsigned pk2(float lo, float hi) { return f2bf(lo) | (f2bf(hi) << 16); }
__device__ __forceinline__ float lo16(unsigned w) { return __builtin_bit_cast(float, w << 16); }
__device__ __forceinline__ float hi16(unsigned w) { return __builtin_bit_cast(float, w & 0xffff0000u); }
__device__ __forceinline__ float sigm(float x) { return 1.f / (1.f + __expf(-x)); }
__device__ __forceinline__ float siluf_(float x) { return x / (1.f + __expf(-x)); }
__device__ __forceinline__ float gelu_tanh(float x) { float u = 0.7978845608028654f * (x + 0.044715f * x * x * x); float t = 1.f - 2.f / (1.f + __expf(2.f * u)); return 0.5f * x * (1.f + t); }
__device__ __forceinline__ float softplusf_(float z) { return fmaxf(z, 0.f) + __logf(1.f + __expf(-fabsf(z))); }
__device__ __forceinline__ float wave_sum(float v) {
#pragma unroll
    for (int o = 1; o < 64; o <<= 1) v += __shfl_xor(v, o);
    return v;
}
#define MFMA16(a, b, c) __builtin_amdgcn_mfma_f32_16x16x32_bf16((a), (b), (c), 0, 0, 0)

namespace pg8 {
constexpr int BM = 256, BK = 64, HALF = 128, HTB = HALF * BK * 2, NXCD = 8, WGM = 8;
__host__ __device__ __forceinline__ int lds_byte(int r, int c) { const int st = (r >> 4) * 2 + (c >> 5), rr = r & 15, cc = c & 31, ob = rr * 64 + cc * 2; return st * 1024 + (ob ^ (((ob >> 9) & 1) << 5)); }
__host__ __device__ __forceinline__ void stage_rc(int b, int& R, int& C) { const int st = b / 1024, sb = b % 1024, swz = sb ^ (((sb >> 9) & 1) << 5); R = (st >> 1) * 16 + swz / 64; C = (st & 1) * 32 + (swz % 64) / 2; }
__host__ __device__ __forceinline__ int perm32(int rho) { const int n = rho >> 4, i = rho & 15; return 8 * (i >> 2) + 4 * n + (i & 3); }

struct Unit { int pm, pn, acol, mode; };
struct Gemm { const bf16_t* A; const bf16_t* Bt; int lda, ldb, K; };

struct StaticOrder {
    int nM, nN, nwg, G, c;
    __device__ void init(int M, int N, int G_, int c_) { nM = M / BM; nN = N / BM; nwg = nM * nN; G = G_; c = c_; }
    __device__ bool next(int i, Unit& u) const {
        const long L = (long)i * G + c; if (L >= nwg) return false;
        int wgid = (int)L; { const int q = nwg / NXCD, r = nwg % NXCD, xcd = wgid % NXCD, off = wgid / NXCD; wgid = (xcd < r ? xcd * (q + 1) : r * (q + 1) + (xcd - r) * q) + off; }
        const int nig = WGM * nN, gid = wgid / nig, fm = gid * WGM, gsz = (nM - fm) < WGM ? (nM - fm) : WGM;
        u.pm = fm + ((wgid % nig) % gsz); u.pn = (wgid % nig) / gsz; u.acol = 0; u.mode = 0; return true;
    }
};
struct BranchOrder {
    int G, c;
    __device__ bool next(int i, Unit& u) const {
        const int L = (i / 5) * G + c; if (L >= 256) return false;
        const int sub = i % 5, pn8 = L & 7; u.pm = L >> 3;
        if (sub == 0) { u.pn = pn8; u.acol = BR_CONV; u.mode = 0; }
        else if (sub == 1) { u.pn = 8 + pn8; u.acol = BR_SB; u.mode = 1; }
        else if (sub == 2) { u.pn = 16 + pn8; u.acol = BR_GLA; u.mode = 2; }
        else { u.pn = 24 + 2 * pn8 + (sub - 3); u.acol = BR_S5; u.mode = 3; }
        return true;
    }
};

template <class Epi, class Sched>
__device__ __forceinline__ void gemm_phase(LAS unsigned char* lds, const Gemm g, const Sched& S, const Epi& E, int tid) {
    const int wid = __builtin_amdgcn_readfirstlane(tid >> 6), lane = tid & 63, wr = wid >> 2, wc = wid & 3, fr = lane & 15, fq = lane >> 4;
    const int K = g.K, nt = K / BK;
    unsigned voffA[2], voffB[2];
#pragma unroll
    for (int i = 0; i < 2; ++i) { int R, C; stage_rc(tid * 16 + i * 8192, R, C); const int Rb = (R & ~31) + perm32(R & 31);
        voffA[i] = (unsigned)(R * g.lda + C) * 2u; voffB[i] = (unsigned)(Rb * g.ldb + C) * 2u; }
    const size_t kstep = (size_t)(BK * 2);
    const size_t hstepA = (size_t)HALF * g.lda * 2, hstepB = (size_t)HALF * g.ldb * 2;
    const size_t tstepA = 2 * hstepA, tstepB = 2 * hstepB;
    const unsigned ldsw = (unsigned)wid * 1024u;
    const int aoff = lds_byte(wr * 64 + fr, fq * 8), boff = lds_byte(wc * 32 + fr, fq * 8);
#define PG8_SA(b, h) (((b) * 2 + (h)) * HTB)
#define PG8_SB(b, h) ((4 + (b) * 2 + (h)) * HTB)
#define PG8_STAGE(bufoff, gbase, voff) do { _Pragma("unroll") for (int _i = 0; _i < 2; ++_i) \
        __builtin_amdgcn_global_load_lds((const unsigned*)((const char*)(gbase) + (voff)[_i]), (LAS unsigned*)(lds + (bufoff) + ldsw + _i * 8192), 16, 0, 0); } while (0)
#define PG8_LDA(dst, b, h) do { _Pragma("unroll") for (int m = 0; m < 4; ++m) _Pragma("unroll") for (int k = 0; k < 2; ++k) dst[m][k] = *(const LAS bf16x8*)(lds + PG8_SA(b, h) + aoff + m * 2048 + k * 1024); } while (0)
#define PG8_LDB(dst, b, h) do { _Pragma("unroll") for (int n = 0; n < 2; ++n) _Pragma("unroll") for (int k = 0; k < 2; ++k) dst[n][k] = *(const LAS bf16x8*)(lds + PG8_SB(b, h) + boff + n * 2048 + k * 1024); } while (0)
#define PG8_MMA(ai, bj, At, Bt) do { __builtin_amdgcn_s_setprio(1); _Pragma("unroll") for (int m = 0; m < 4; ++m) _Pragma("unroll") for (int n = 0; n < 2; ++n) _Pragma("unroll") for (int k = 0; k < 2; ++k) \
        acc[ai][bj][m][n] = __builtin_amdgcn_mfma_f32_16x16x32_bf16(Bt[n][k], At[m][k], acc[ai][bj][m][n], 0, 0, 0); __builtin_amdgcn_s_setprio(0); } while (0)
#define PG8_WAIT_V(n) asm volatile("s_waitcnt vmcnt(" #n ")" ::: "memory")
#define PG8_WAIT_L(n) asm volatile("s_waitcnt lgkmcnt(" #n ")" ::: "memory")
#define PG8_BAR __builtin_amdgcn_s_barrier()
#define PG8_SCHED __builtin_amdgcn_sched_barrier(0)
    Unit cur, nxt; int ui = 0;
    if (!S.next(0, cur)) return;
    f32x4 acc[2][2][4][2];
#pragma unroll
    for (int a = 0; a < 2; ++a)
#pragma unroll
        for (int b = 0; b < 2; ++b)
#pragma unroll
            for (int m = 0; m < 4; ++m)
#pragma unroll
                for (int n = 0; n < 2; ++n) acc[a][b][m][n] = (f32x4){0.f, 0.f, 0.f, 0.f};
    bf16x8 At[4][2], B0[2][2], B1[2][2];
    const char* cA = (const char*)g.A + (size_t)cur.pm * tstepA + (size_t)cur.acol * 2; const char* cB = (const char*)g.Bt + (size_t)cur.pn * tstepB;
    PG8_STAGE(PG8_SB(0, 0), cB, voffB); PG8_STAGE(PG8_SB(0, 1), cB + hstepB, voffB); PG8_STAGE(PG8_SA(0, 0), cA, voffA); PG8_STAGE(PG8_SA(0, 1), cA + hstepA, voffA);
    if (wr == 1) PG8_BAR;
    PG8_WAIT_V(2); PG8_BAR;
    PG8_STAGE(PG8_SB(1, 0), cB + kstep, voffB); PG8_STAGE(PG8_SA(1, 0), cA + kstep, voffA); PG8_STAGE(PG8_SB(1, 1), cB + hstepB + kstep, voffB);
    PG8_WAIT_V(6); PG8_BAR;
    for (;;) {
        const bool has_next = S.next(ui + 1, nxt);
        const char* nA = has_next ? (const char*)g.A + (size_t)nxt.pm * tstepA + (size_t)nxt.acol * 2 : cA; const char* nB = has_next ? (const char*)g.Bt + (size_t)nxt.pn * tstepB : cB;
        for (int t = 0; t < nt; t += 2) {
            const bool last = (t == nt - 2);
            const char* a1 = cA + (size_t)(t + 1) * kstep;
            const char* a2 = last ? nA : cA + (size_t)(t + 2) * kstep; const char* b2 = last ? nB : cB + (size_t)(t + 2) * kstep;
            const char* a3 = a2 + kstep; const char* b3 = b2 + kstep;
            PG8_LDB(B0, 0, 0); PG8_LDB(B1, 0, 1); PG8_SCHED; PG8_LDA(At, 0, 0); PG8_STAGE(PG8_SA(1, 1), a1 + hstepA, voffA);
            PG8_WAIT_V(8); PG8_WAIT_L(0); PG8_BAR; PG8_MMA(0, 0, At, B0); PG8_MMA(0, 1, At, B1); PG8_BAR; PG8_SCHED;
            PG8_LDA(At, 0, 1); PG8_STAGE(PG8_SB(0, 0), b2, voffB); PG8_STAGE(PG8_SB(0, 1), b2 + hstepB, voffB); PG8_STAGE(PG8_SA(0, 0), a2, voffA);
            PG8_WAIT_V(8); PG8_WAIT_L(0); PG8_BAR; PG8_MMA(1, 0, At, B0); PG8_MMA(1, 1, At, B1); PG8_BAR; PG8_SCHED;
            PG8_LDB(B0, 1, 0); PG8_LDB(B1, 1, 1); PG8_SCHED; PG8_LDA(At, 1, 0); PG8_STAGE(PG8_SA(0, 1), a2 + hstepA, voffA);
            PG8_WAIT_V(8); PG8_WAIT_L(0); PG8_BAR; PG8_MMA(0, 0, At, B0); PG8_MMA(0, 1, At, B1); PG8_BAR; PG8_SCHED;
            PG8_LDA(At, 1, 1); PG8_STAGE(PG8_SB(1, 0), b3, voffB); PG8_STAGE(PG8_SB(1, 1), b3 + hstepB, voffB); PG8_STAGE(PG8_SA(1, 0), a3, voffA);
            PG8_WAIT_V(8); PG8_WAIT_L(0); PG8_BAR; PG8_MMA(1, 0, At, B0); PG8_MMA(1, 1, At, B1); PG8_BAR; PG8_SCHED;
        }
        E(acc, cur, wr, wc, fr, fq);
        if (!has_next) break;
#pragma unroll
        for (int a = 0; a < 2; ++a)
#pragma unroll
            for (int b = 0; b < 2; ++b)
#pragma unroll
                for (int m = 0; m < 4; ++m)
#pragma unroll
                    for (int n = 0; n < 2; ++n) acc[a][b][m][n] = (f32x4){0.f, 0.f, 0.f, 0.f};
        cur = nxt; cA = nA; cB = nB; ++ui;
    }
    PG8_WAIT_V(0);
    if (wr == 0) PG8_BAR;
    PG8_BAR;
#undef PG8_SA
#undef PG8_SB
#undef PG8_STAGE
#undef PG8_LDA
#undef PG8_LDB
#undef PG8_MMA
#undef PG8_WAIT_V
#undef PG8_WAIT_L
#undef PG8_BAR
#undef PG8_SCHED
}

struct EpiBf16 {
    bf16_t* O; int ldc;
    __device__ __forceinline__ void operator()(const f32x4 (&acc)[2][2][4][2], const Unit& u, int wr, int wc, int fr, int fq) const {
        const int row0 = u.pm * BM + wr * 64 + fr, col0 = u.pn * BM + wc * 32 + 8 * fq;
#pragma unroll
        for (int ai = 0; ai < 2; ++ai)
#pragma unroll
            for (int m = 0; m < 4; ++m) { bf16_t* rowp = O + (size_t)(row0 + ai * HALF + m * 16) * ldc + col0;
#pragma unroll
                for (int bj = 0; bj < 2; ++bj) { const f32x4 v0 = acc[ai][bj][m][0], v1 = acc[ai][bj][m][1];
                    u32x4 w; w.x = pk2(v0[0], v0[1]); w.y = pk2(v0[2], v0[3]); w.z = pk2(v1[0], v1[1]); w.w = pk2(v1[2], v1[3]);
                    *(u32x4*)(rowp + bj * HALF) = w; } }
    }
};
struct EpiGateUp {
    bf16_t* O;
    __device__ __forceinline__ void operator()(const f32x4 (&acc)[2][2][4][2], const Unit& u, int wr, int wc, int fr, int fq) const {
        const int row0 = u.pm * BM + wr * 64 + fr, col0 = u.pn * HALF + wc * 32 + 8 * fq;
#pragma unroll
        for (int ai = 0; ai < 2; ++ai)
#pragma unroll
            for (int m = 0; m < 4; ++m) { bf16_t* rowp = O + (size_t)(row0 + ai * HALF + m * 16) * DFF + col0;
                float r[8];
#pragma unroll
                for (int n = 0; n < 2; ++n)
#pragma unroll
                    for (int i = 0; i < 4; ++i) r[n * 4 + i] = siluf_(acc[ai][0][m][n][i]) * acc[ai][1][m][n][i];
                u32x4 w; w.x = pk2(r[0], r[1]); w.y = pk2(r[2], r[3]); w.z = pk2(r[4], r[5]); w.w = pk2(r[6], r[7]);
                *(u32x4*)rowp = w; }
    }
};
struct EpiResid {
    const float* X; const float* gate; float* Y;
    __device__ __forceinline__ void operator()(const f32x4 (&acc)[2][2][4][2], const Unit& u, int wr, int wc, int fr, int fq) const {
        const int row0 = u.pm * BM + wr * 64 + fr, col0 = u.pn * BM + wc * 32 + 8 * fq;
        const float* gp = gate + (size_t)(u.pm >> 3) * 12288 + col0;
#pragma unroll
        for (int bj = 0; bj < 2; ++bj) {
            const f32x4 g0 = *(const f32x4*)(gp + bj * HALF), g1 = *(const f32x4*)(gp + bj * HALF + 4);
#pragma unroll
            for (int ai = 0; ai < 2; ++ai)
#pragma unroll
                for (int m = 0; m < 4; ++m) { const size_t off = (size_t)(row0 + ai * HALF + m * 16) * DM + col0 + bj * HALF;
                    const f32x4 x0 = *(const f32x4*)(X + off), x1 = *(const f32x4*)(X + off + 4);
                    *(f32x4*)(Y + off) = x0 * ALPHA + g0 * acc[ai][bj][m][0];
                    *(f32x4*)(Y + off + 4) = x1 * ALPHA + g1 * acc[ai][bj][m][1]; }
        }
    }
};
struct EpiBranch {
    const bf16_t* P; float* MG; bf16_t* MBF;
    __device__ __forceinline__ void operator()(const f32x4 (&acc)[2][2][4][2], const Unit& u, int wr, int wc, int fr, int fq) const {
        const int row0 = u.pm * BM + wr * 64 + fr;
        if (u.mode < 3) {
            const int col0 = u.pn * BM - u.mode * 2048 + wc * 32 + 8 * fq;
            const int gcol = (u.mode == 0 ? C_GCONV : (u.mode == 1 ? C_GSB : C_GGLA));
#pragma unroll
            for (int ai = 0; ai < 2; ++ai)
#pragma unroll
                for (int m = 0; m < 4; ++m) { const int row = row0 + ai * HALF + m * 16;
#pragma unroll
                    for (int bj = 0; bj < 2; ++bj) { const int c = col0 + bj * HALF;
                        const u32x4 gw = *(const u32x4*)(P + (size_t)row * NPROJ + gcol + c);
                        f32x4 r0, r1;
                        r0[0] = sigm(lo16(gw.x)) * acc[ai][bj][m][0][0]; r0[1] = sigm(hi16(gw.x)) * acc[ai][bj][m][0][1];
                        r0[2] = sigm(lo16(gw.y)) * acc[ai][bj][m][0][2]; r0[3] = sigm(hi16(gw.y)) * acc[ai][bj][m][0][3];
                        r1[0] = sigm(lo16(gw.z)) * acc[ai][bj][m][1][0]; r1[1] = sigm(hi16(gw.z)) * acc[ai][bj][m][1][1];
                        r1[2] = sigm(lo16(gw.w)) * acc[ai][bj][m][1][2]; r1[3] = sigm(hi16(gw.w)) * acc[ai][bj][m][1][3];
                        float* mp = MG + (size_t)row * DM + c;
                        if (u.mode != 0) { r0 += *(const f32x4*)mp; r1 += *(const f32x4*)(mp + 4); }
                        *(f32x4*)mp = r0; *(f32x4*)(mp + 4) = r1; } }
        } else {
            const int col0 = (u.pn - 24) * HALF + wc * 32 + 8 * fq;
#pragma unroll
            for (int ai = 0; ai < 2; ++ai)
#pragma unroll
                for (int m = 0; m < 4; ++m) { const int row = row0 + ai * HALF + m * 16;
                    const u32x4 gw = *(const u32x4*)(P + (size_t)row * NPROJ + C_GS5 + col0);
                    const float* mp = MG + (size_t)row * DM + col0;
                    const f32x4 m0 = *(const f32x4*)mp, m1 = *(const f32x4*)(mp + 4);
                    float r[8];
                    r[0] = m0[0] + sigm(lo16(gw.x)) * acc[ai][0][m][0][0] * sigm(acc[ai][1][m][0][0]);
                    r[1] = m0[1] + sigm(hi16(gw.x)) * acc[ai][0][m][0][1] * sigm(acc[ai][1][m][0][1]);
                    r[2] = m0[2] + sigm(lo16(gw.y)) * acc[ai][0][m][0][2] * sigm(acc[ai][1][m][0][2]);
                    r[3] = m0[3] + sigm(hi16(gw.y)) * acc[ai][0][m][0][3] * sigm(acc[ai][1][m][0][3]);
                    r[4] = m1[0] + sigm(lo16(gw.z)) * acc[ai][0][m][1][0] * sigm(acc[ai][1][m][1][0]);
                    r[5] = m1[1] + sigm(hi16(gw.z)) * acc[ai][0][m][1][1] * sigm(acc[ai][1][m][1][1]);
                    r[6] = m1[2] + sigm(lo16(gw.w)) * acc[ai][0][m][1][2] * sigm(acc[ai][1][m][1][2]);
                    r[7] = m1[3] + sigm(hi16(gw.w)) * acc[ai][0][m][1][3] * sigm(acc[ai][1][m][1][3]);
                    u32x4 w; w.x = pk2(r[0], r[1]); w.y = pk2(r[2], r[3]); w.z = pk2(r[4], r[5]); w.w = pk2(r[6], r[7]);
                    *(u32x4*)(MBF + (size_t)row * DM + col0) = w; }
        }
    }
};
}

struct Args { const float* in[30]; float* out; unsigned char* ws; int ph_lo, ph_hi; };
enum { I_X = 0, I_C, I_ADAW, I_ADAB, I_WIN, I_CONVW, I_WCO, I_LRE, I_LIM, I_BRE, I_BIM, I_CRE, I_CIM, I_S5D, I_LOGDT, I_WS5V, I_WS5G, I_WSB,
       I_GLAWG, I_GLABG, I_GLANG, I_WGLA, I_WO, I_LN1G, I_LN1B, I_FFG, I_FFU, I_FFD, I_LN2G, I_LN2B };

__device__ __forceinline__ void tr_item(const float* srcp, int ld, int k0, bf16_t* WT, int Kd, int n0, float* scr, int lane) {
    const int r4 = lane >> 4, n4 = (lane & 15) * 4;
    f32x4 v[16];
#pragma unroll
    for (int i = 0; i < 16; ++i) v[i] = srcp ? *(const f32x4*)(srcp + (size_t)(k0 + 4 * i + r4) * ld) : (f32x4){0.f, 0.f, 0.f, 0.f};
#pragma unroll
    for (int i = 0; i < 16; ++i) { float* d = scr + (4 * i + r4) * 65 + n4; d[0] = v[i][0]; d[1] = v[i][1]; d[2] = v[i][2]; d[3] = v[i][3]; }
    __builtin_amdgcn_s_waitcnt(0); asm volatile("" ::: "memory");
    const int c = lane & 7;
#pragma unroll
    for (int j = 0; j < 8; ++j) { const int n = (lane >> 3) + 8 * j; const float* s = scr + (8 * c) * 65 + n;
        u32x4 o; o.x = pk2(s[0 * 65], s[1 * 65]); o.y = pk2(s[2 * 65], s[3 * 65]); o.z = pk2(s[4 * 65], s[5 * 65]); o.w = pk2(s[6 * 65], s[7 * 65]);
        *(u32x4*)(WT + (size_t)(n0 + n) * Kd + k0 + 8 * c) = o; }
    __builtin_amdgcn_s_waitcnt(0); asm volatile("" ::: "memory");
}

__device__ __forceinline__ void p0_transposes(const Args& a, unsigned char* smem, int gw, int ngw, int wave, int lane) {
    float* scr = (float*)(smem + wave * 16640);
    constexpr int C0 = 32 * 292, C1 = 16 * 160, C2 = 32 * 32, C3 = 32 * 176, C4 = 88 * 32, CL = C0 + C1 + C2 + C3 + C4;
    for (int it = gw; it < 2 * CL; it += ngw) {
        const int l = it / CL; int r = it % CL;
        unsigned char* wl = a.ws + WS_W + (size_t)l * W_LAYER;
        const int nl = (lane & 15) * 4;
        if (r < C0) { const int kb = r / 292, nb = r % 292, j = nb * 64 + nl;
            const float* base = a.in[I_WIN] + (size_t)l * DM * NIN;
            const float* sp = j < 10240 ? base + j : (j < 18432 ? base + j + 16 : (j < 18448 ? base + (j - 8192) : nullptr));
            tr_item(sp, NIN, kb * 64, (bf16_t*)(wl + WO_WIN), DM, nb * 64, scr, lane); continue; }
        r -= C0;
        if (r < C1) { const int kb = r / 160, nb = r % 160, j = nb * 64 + nl; const float* sp;
            if (j < 2048) sp = a.in[I_WCO] + (size_t)l * 1024 * DM + j;
            else if (j < 4096) sp = a.in[I_WSB] + (size_t)l * 1024 * DM + (j - 2048);
            else if (j < 6144) sp = a.in[I_WGLA] + (size_t)l * 1024 * DM + (j - 4096);
            else { const int rr = j - 6144, tile = rr >> 8, w = rr & 255; sp = (w < 128 ? a.in[I_WS5V] : a.in[I_WS5G]) + (size_t)l * 1024 * DM + tile * 128 + (w & 127); }
            tr_item(sp, DM, kb * 64, (bf16_t*)(wl + WO_WBR), 1024, nb * 64, scr, lane); continue; }
        r -= C1;
        if (r < C2) { const int kb = r / 32, nb = r % 32, j = nb * 64 + nl;
            tr_item(a.in[I_WO] + (size_t)l * DM * DM + j, DM, kb * 64, (bf16_t*)(wl + WO_WO), DM, nb * 64, scr, lane); continue; }
        r -= C2;
        if (r < C3) { const int kb = r / 176, nb = r % 176, j = nb * 64 + nl; const int tile = j >> 8, w = j & 255;
            const float* sp = (w < 128 ? a.in[I_FFG] : a.in[I_FFU]) + (size_t)l * DM * DFF + tile * 128 + (w & 127);
            tr_item(sp, DFF, kb * 64, (bf16_t*)(wl + WO_WGU), DM, nb * 64, scr, lane); continue; }
        r -= C3;
        { const int kb = r / 32, nb = r % 32, j = nb * 64 + nl;
            tr_item(a.in[I_FFD] + (size_t)l * DFF * DM + j, DM, kb * 64, (bf16_t*)(wl + WO_WD), DFF, nb * 64, scr, lane); }
    }
}

__device__ __forceinline__ void p0_adaln_item(const Args& a, unsigned char* smem, int item, int tid) {
    const int lane = tid & 63, w = tid >> 6;
    float* sc = (float*)smem;
    float* red = (float*)(smem + 32768);
    const int l = item / 192, col0 = (item % 192) * 64;
    const float* wp = a.in[I_ADAW] + (size_t)l * DM * 12288 + col0 + lane;
    float acc0 = 0.f, acc1 = 0.f, acc2 = 0.f, acc3 = 0.f;
    const int k0 = w * 256;
#pragma unroll 8
    for (int k = k0; k < k0 + 256; ++k) { const float wv = wp[(size_t)k * 12288];
        acc0 += sc[k] * wv; acc1 += sc[2048 + k] * wv; acc2 += sc[4096 + k] * wv; acc3 += sc[6144 + k] * wv; }
    red[(w * 4 + 0) * 64 + lane] = acc0; red[(w * 4 + 1) * 64 + lane] = acc1; red[(w * 4 + 2) * 64 + lane] = acc2; red[(w * 4 + 3) * 64 + lane] = acc3;
    __syncthreads();
    if (tid < 256) { const int b = tid >> 6, col = tid & 63; float s = a.in[I_ADAB][l * 12288 + col0 + col];
#pragma unroll
        for (int ww = 0; ww < 8; ++ww) s += red[(ww * 4 + b) * 64 + col];
        ((float*)(a.ws + WS_MOD))[(size_t)(l * 4 + b) * 12288 + col0 + col] = s; }
    __syncthreads();
}

__device__ __forceinline__ void p0_s5pre_item(const Args& a, unsigned char* smem, int item, int tid) {
    const int l = item >> 6, g = item & 63, lg = l * 64 + g;
    float2* Bb = (float2*)(smem + 40960);
    float2* Cc = Bb + 1024;
    float2* Pw = Cc + 1024;
    float* Kt = (float*)(Pw + 17 * 64);
    float2* Ff = (float2*)(Kt + 4096);
    unsigned char* s5w = a.ws + WS_S5M + (size_t)l * S5_LAYER;
    if (tid < 64) { const int p = tid;
        const double dt = exp((double)a.in[I_LOGDT][lg]);
        const double lr = (double)a.in[I_LRE][lg * 64 + p], li = (double)a.in[I_LIM][lg * 64 + p];
        const double rev = li * dt * 0.15915494309189535;
        double abr = 0.0, abi = 0.0;
        for (int tau = 0; tau <= 16; ++tau) { const double mg = exp(lr * dt * tau); double x = rev * tau; x -= rint(x);
            const double s = sinpi(2.0 * x), c = cospi(2.0 * x);
            Pw[tau * 64 + p] = make_float2((float)(mg * c), (float)(mg * s));
            if (tau == 1) { abr = mg * c; abi = mg * s; } }
        const double den = lr * lr + li * li, nr = abr - 1.0, ni = abi;
        Ff[p] = make_float2((float)((nr * lr + ni * li) / den), (float)((ni * lr - nr * li) / den));
        ((float2*)(s5w + S5O_A16))[g * 64 + p] = Pw[16 * 64 + p];
    }
    __syncthreads();
    for (int e = tid; e < 1024; e += 512) { const int p = e >> 4;
        const float br = a.in[I_BRE][(size_t)lg * 1024 + e], bi = a.in[I_BIM][(size_t)lg * 1024 + e]; const float2 f = Ff[p];
        Bb[e] = make_float2(f.x * br - f.y * bi, f.x * bi + f.y * br);
        Cc[e] = make_float2(a.in[I_CRE][(size_t)lg * 1024 + e], a.in[I_CIM][(size_t)lg * 1024 + e]); }
    __syncthreads();
    for (int idx = tid; idx < 4096; idx += 512) { const int tau = idx >> 8, h = (idx >> 4) & 15, hp = idx & 15; float s = 0.f;
        for (int p = 0; p < 64; ++p) { const float2 c = Cc[h * 64 + p], w = Pw[tau * 64 + p], b = Bb[p * 16 + hp];
            const float cr = c.x * w.x - c.y * w.y, ci = c.x * w.y + c.y * w.x; s += cr * b.x - ci * b.y; }
        Kt[idx] = s; }
    __syncthreads();
    {
        bf16_t* MR = (bf16_t*)(s5w + S5O_MROW) + (size_t)g * 256 * 384;
        for (int e2 = tid; e2 < 256 * 192; e2 += 512) { const int n = e2 / 192, k2 = (e2 % 192) * 2; const int i = n >> 4, h = n & 15; float v[2];
#pragma unroll
            for (int u = 0; u < 2; ++u) { const int k = k2 + u;
                if (k < 256) { const int j = k >> 4, hp = k & 15; v[u] = (i >= j) ? Kt[(i - j) * 256 + h * 16 + hp] : 0.f; }
                else if (k < 320) { const int p = k - 256; const float2 c = Cc[h * 64 + p], w = Pw[(i + 1) * 64 + p]; v[u] = c.x * w.x - c.y * w.y; }
                else { const int p = k - 320; const float2 c = Cc[h * 64 + p], w = Pw[(i + 1) * 64 + p]; v[u] = -(c.x * w.y + c.y * w.x); } }
            *(unsigned*)(MR + (size_t)n * 384 + k2) = pk2(v[0], v[1]); }
        bf16_t* MI = (bf16_t*)(s5w + S5O_MIN) + (size_t)g * 128 * 256;
        for (int e2 = tid; e2 < 128 * 128; e2 += 512) { const int n2 = e2 >> 7, k2 = (e2 & 127) * 2; const int p = n2 & 63; float v[2];
#pragma unroll
            for (int u = 0; u < 2; ++u) { const int k = k2 + u, j = k >> 4, hp = k & 15; const float2 w = Pw[(15 - j) * 64 + p], b = Bb[p * 16 + hp];
                v[u] = (n2 < 64) ? (w.x * b.x - w.y * b.y) : (w.x * b.y + w.y * b.x); }
            *(unsigned*)(MI + (size_t)n2 * 256 + k2) = pk2(v[0], v[1]); }
    }
    __syncthreads();
}

__device__ __forceinline__ void ln_stats(const f32x4 (&v)[8], float& mean, float& rstd) {
    float s = 0.f;
#pragma unroll
    for (int j = 0; j < 8; ++j) s += (v[j][0] + v[j][1]) + (v[j][2] + v[j][3]);
    mean = wave_sum(s) * (1.f / DM); float q = 0.f;
#pragma unroll
    for (int j = 0; j < 8; ++j) { const f32x4 d = v[j] - mean; q += (d[0] * d[0] + d[1] * d[1]) + (d[2] * d[2] + d[3] * d[3]); }
    rstd = rsqrtf(wave_sum(q) * (1.f / DM) + 1e-5f);
}
__device__ __forceinline__ void ln_mod_store(const f32x4 (&v)[8], const float* sc, const float* sh, bf16_t* hrow, int lane) {
    float mean, rstd; ln_stats(v, mean, rstd);
#pragma unroll
    for (int j = 0; j < 8; ++j) { const int c = 4 * lane + 256 * j; const f32x4 s = *(const f32x4*)(sc + c), t = *(const f32x4*)(sh + c);
        const f32x4 y = (v[j] - mean) * rstd * (s + 1.f) + t; u32x2 w; w.x = pk2(y[0], y[1]); w.y = pk2(y[2], y[3]); *(u32x2*)(hrow + c) = w; }
}
__device__ __forceinline__ void ln_phase(const float* in, const float* g, const float* bta, float* xo, const float* modsc, const float* modsh, bf16_t* H, int gw, int ngw, int lane) {
    for (int m = gw; m < MTOK; m += ngw) {
        f32x4 v[8];
#pragma unroll
        for (int j = 0; j < 8; ++j) v[j] = *(const f32x4*)(in + (size_t)m * DM + 4 * lane + 256 * j);
        if (g) { float mean, rstd; ln_stats(v, mean, rstd);
#pragma unroll
            for (int j = 0; j < 8; ++j) { const int c = 4 * lane + 256 * j; const f32x4 gg = *(const f32x4*)(g + c), bb = *(const f32x4*)(bta + c);
                v[j] = (v[j] - mean) * rstd * gg + bb; *(f32x4*)(xo + (size_t)m * DM + c) = v[j]; } }
        if (modsc) { const int b = m >> 11; ln_mod_store(v, modsc + (size_t)b * 12288, modsh + (size_t)b * 12288, H + (size_t)m * DM, lane); }
    }
}

__device__ __forceinline__ void conv_item(const bf16_t* P, bf16_t* BR, const float* cw, int it, int tid) {
    const int idx = it * 512 + tid, m = idx >> 7, c8 = (idx & 127) * 8, t = m & (SEQ - 1);
    const bf16_t* pr = P + (size_t)m * NPROJ;
    float accv[8];
#pragma unroll
    for (int i = 0; i < 8; ++i) accv[i] = 0.f;
#pragma unroll
    for (int j = 0; j < 3; ++j) { const int dtk = 2 - j; if (t - dtk < 0) continue;
        const bf16_t* pj = pr - (size_t)dtk * NPROJ;
        const u32x4 cc = *(const u32x4*)(pj + C_CVC + c8), xx = *(const u32x4*)(pj + C_CVX + c8);
        const f32x4 w0 = *(const f32x4*)(cw + j * 1024 + c8), w1 = *(const f32x4*)(cw + j * 1024 + c8 + 4);
        accv[0] += w0[0] * lo16(cc.x) * lo16(xx.x); accv[1] += w0[1] * hi16(cc.x) * hi16(xx.x);
        accv[2] += w0[2] * lo16(cc.y) * lo16(xx.y); accv[3] += w0[3] * hi16(cc.y) * hi16(xx.y);
        accv[4] += w1[0] * lo16(cc.z) * lo16(xx.z); accv[5] += w1[1] * hi16(cc.z) * hi16(xx.z);
        accv[6] += w1[2] * lo16(cc.w) * lo16(xx.w); accv[7] += w1[3] * hi16(cc.w) * hi16(xx.w); }
    const u32x4 bb = *(const u32x4*)(pr + C_CVB + c8);
    u32x4 o; o.x = pk2(accv[0] * lo16(bb.x), accv[1] * hi16(bb.x)); o.y = pk2(accv[2] * lo16(bb.y), accv[3] * hi16(bb.y));
    o.z = pk2(accv[4] * lo16(bb.z), accv[5] * hi16(bb.z)); o.w = pk2(accv[6] * lo16(bb.w), accv[7] * hi16(bb.w));
    *(u32x4*)(BR + (size_t)m * NBR + BR_CONV + c8) = o;
}

__device__ __forceinline__ void s5a_item(const bf16_t* P, const bf16_t* MIN, float* SLOC, int wi, int lane) {
    const int g = wi >> 5, ct = wi & 31, c16 = lane & 15, q = lane >> 4;
    const int cc = ct * 16 + c16, b = cc >> 7, c = cc & 127;
    bf16x8 bf[8];
#pragma unroll
    for (int ks = 0; ks < 8; ++ks) bf[ks] = *(const bf16x8*)(P + (size_t)(b * SEQ + c * 16 + 2 * ks + (q >> 1)) * NPROJ + C_S5U + g * 16 + (q & 1) * 8);
    const bf16_t* Mg = MIN + (size_t)g * 128 * 256;
    float* out = SLOC + ((size_t)(b * 128 + c) * 64 + g) * 128;
#pragma unroll
    for (int rt = 0; rt < 8; ++rt) { f32x4 acc = {0.f, 0.f, 0.f, 0.f};
#pragma unroll
        for (int ks = 0; ks < 8; ++ks) { const bf16x8 af = *(const bf16x8*)(Mg + (size_t)(16 * rt + c16) * 256 + 32 * ks + 8 * q); acc = MFMA16(af, bf[ks], acc); }
        *(f32x4*)(out + 16 * rt + 4 * q) = acc; }
}

__device__ __forceinline__ void s5c_item(const bf16_t* P, const bf16_t* MROW, const bf16_t* SPREV, const float* dsk, bf16_t* BR, int wi, int lane) {
    const int g = wi >> 5, ct = wi & 31, c16 = lane & 15, q = lane >> 4;
    const int cc = ct * 16 + c16, b = cc >> 7, c = cc & 127;
    bf16x8 bf[12];
#pragma unroll
    for (int ks = 0; ks < 8; ++ks) bf[ks] = *(const bf16x8*)(P + (size_t)(b * SEQ + c * 16 + 2 * ks + (q >> 1)) * NPROJ + C_S5U + g * 16 + (q & 1) * 8);
    const bf16_t* sp = SPREV + ((size_t)(b * 128 + c) * 64 + g) * 128;
#pragma unroll
    for (int ks = 0; ks < 4; ++ks) bf[8 + ks] = *(const bf16x8*)(sp + 32 * ks + 8 * q);
    const bf16_t* Mg = MROW + (size_t)g * 256 * 384;
    const f32x4 dv = *(const f32x4*)(dsk + g * 16 + 4 * q);
#pragma unroll
    for (int i = 0; i < 16; ++i) { f32x4 acc = {0.f, 0.f, 0.f, 0.f};
        const bf16_t* mrow = Mg + (size_t)(16 * i + c16) * 384 + 8 * q;
#pragma unroll
        for (int ks = 0; ks < 8; ++ks) if (ks <= (i >> 1)) { const bf16x8 af = *(const bf16x8*)(mrow + 32 * ks); acc = MFMA16(af, bf[ks], acc); }
#pragma unroll
        for (int ks = 8; ks < 12; ++ks) { const bf16x8 af = *(const bf16x8*)(mrow + 32 * ks); acc = MFMA16(af, bf[ks], acc); }
        const size_t m = (size_t)b * SEQ + c * 16 + i;
        const u32x2 uw = *(const u32x2*)(P + m * NPROJ + C_S5U + g * 16 + 4 * q);
        const float y0 = acc[0] + dv[0] * lo16(uw.x), y1 = acc[1] + dv[1] * hi16(uw.x), y2 = acc[2] + dv[2] * lo16(uw.y), y3 = acc[3] + dv[3] * hi16(uw.y);
        u32x2 o; o.x = pk2(gelu_tanh(y0), gelu_tanh(y1)); o.y = pk2(gelu_tanh(y2), gelu_tanh(y3));
        *(u32x2*)(BR + m * NBR + BR_S5 + g * 16 + 4 * q) = o; }
}

__device__ __forceinline__ void stage_vt64(const bf16_t* P, size_t m0, int vcol0, bf16_t* VT, int tid) {
#pragma unroll
    for (int i = 0; i < 4; ++i) { const int id = tid + 512 * i, t = id >> 5, v8 = (id & 31) * 8;
        const u32x4 vv = *(const u32x4*)(P + (m0 + t) * NPROJ + vcol0 + v8);
        VT[(v8 + 0) * 72 + t] = (bf16_t)(vv.x & 0xffffu); VT[(v8 + 1) * 72 + t] = (bf16_t)(vv.x >> 16);
        VT[(v8 + 2) * 72 + t] = (bf16_t)(vv.y & 0xffffu); VT[(v8 + 3) * 72 + t] = (bf16_t)(vv.y >> 16);
        VT[(v8 + 4) * 72 + t] = (bf16_t)(vv.z & 0xffffu); VT[(v8 + 5) * 72 + t] = (bf16_t)(vv.z >> 16);
        VT[(v8 + 6) * 72 + t] = (bf16_t)(vv.w & 0xffffu); VT[(v8 + 7) * 72 + t] = (bf16_t)(vv.w >> 16); }
}

__device__ __forceinline__ void glaa_item(const bf16_t* P, const float* wgate, const float* bgate, float* BCUM, float* AEND, float* LCT, unsigned char* smem, int it, int tid) {
    const int bh = it >> 5, cn = it & 31, b = bh >> 2, h = bh & 3; const size_t m0 = (size_t)b * SEQ + cn * 64;
    const int lane = tid & 63, w = tid >> 6, c16 = lane & 15, q = lane >> 4;
    float* lrs = (float*)smem;
    float* part = (float*)(smem + 4096);
    bf16_t* KdT = (bf16_t*)(smem + 8192);
    bf16_t* VT = (bf16_t*)(smem + 8192 + 18432);
    if (tid < 128) { const int t = tid >> 1, hf = tid & 1; const u32x4 v = *(const u32x4*)(P + (m0 + t) * NPROJ + C_GLLR + hf * 8);
        float* d = lrs + t * 16 + hf * 8; d[0] = lo16(v.x); d[1] = hi16(v.x); d[2] = lo16(v.y); d[3] = hi16(v.y); d[4] = lo16(v.z); d[5] = hi16(v.z); d[6] = lo16(v.w); d[7] = hi16(v.w); }
    stage_vt64(P, m0, C_GLV + h * 256, VT, tid);
    __syncthreads();
    const int k = tid & 127, tg = tid >> 7;
    float wg[16];
#pragma unroll
    for (int r = 0; r < 16; ++r) wg[r] = wgate[r * 512 + h * 128 + k];
    const float bias = bgate[h * 128 + k];
    float bl[16]; float run = 0.f;
#pragma unroll
    for (int tt = 0; tt < 16; ++tt) { const float* lr = lrs + (16 * tg + tt) * 16; float z = bias;
#pragma unroll
        for (int r = 0; r < 16; ++r) z += lr[r] * wg[r];
        const float la = (fminf(z, 0.f) - __logf(1.f + __expf(-fabsf(z)))) * (1.f / 16.f);
        run += la; bl[tt] = run; }
    part[tg * 128 + k] = run;
    __syncthreads();
    float off = 0.f, bend = 0.f;
#pragma unroll
    for (int g2 = 0; g2 < 4; ++g2) { const float pv = part[g2 * 128 + k]; bend += pv; if (g2 < tg) off += pv; }
    if (tg == 0) AEND[(size_t)(bh * 32 + cn) * 128 + k] = __expf(bend);
    unsigned kd[8];
#pragma unroll
    for (int tt = 0; tt < 16; tt += 2) {
        const float b0 = bl[tt] + off, b1 = bl[tt + 1] + off; const size_t t0 = m0 + 16 * tg + tt;
        BCUM[t0 * 512 + h * 128 + k] = b0; BCUM[(t0 + 1) * 512 + h * 128 + k] = b1;
        const float k0v = bf2f(P[t0 * NPROJ + C_GLK + h * 128 + k]), k1v = bf2f(P[(t0 + 1) * NPROJ + C_GLK + h * 128 + k]);
        kd[tt >> 1] = pk2(k0v * __expf(bend - b0), k1v * __expf(bend - b1)); }
    { u32x4 w0, w1; w0.x = kd[0]; w0.y = kd[1]; w0.z = kd[2]; w0.w = kd[3]; w1.x = kd[4]; w1.y = kd[5]; w1.z = kd[6]; w1.w = kd[7];
      *(u32x4*)(KdT + k * 72 + 16 * tg) = w0; *(u32x4*)(KdT + k * 72 + 16 * tg + 8) = w1; }
    __syncthreads();
    float* out = LCT + (size_t)(bh * 32 + cn) * 32768;
#pragma unroll
    for (int vi = 0; vi < 2; ++vi) { const int vt = 2 * w + vi;
        const bf16x8 a0 = *(const bf16x8*)(VT + (16 * vt + c16) * 72 + 8 * q), a1 = *(const bf16x8*)(VT + (16 * vt + c16) * 72 + 32 + 8 * q);
#pragma unroll
        for (int kt = 0; kt < 8; ++kt) { f32x4 acc = {0.f, 0.f, 0.f, 0.f};
            const bf16x8 b0 = *(const bf16x8*)(KdT + (16 * kt + c16) * 72 + 8 * q), b1 = *(const bf16x8*)(KdT + (16 * kt + c16) * 72 + 32 + 8 * q);
            acc = MFMA16(a0, b0, acc); acc = MFMA16(a1, b1, acc);
#pragma unroll
            for (int j = 0; j < 4; ++j) out[(size_t)(16 * vt + 4 * q + j) * 128 + 16 * kt + c16] = acc[j]; } }
    __syncthreads();
}

__device__ __forceinline__ void glac_item(const bf16_t* P, const float* BCUM, const bf16_t* SNT, const float* gn, bf16_t* BR, unsigned char* smem, int it, int tid) {
    const int bh = it >> 5, cn = it & 31, b = bh >> 2, h = bh & 3; const size_t m0 = (size_t)b * SEQ + cn * 64;
    const int lane = tid & 63, w = tid >> 6, c16 = lane & 15, q = lane >> 4;
    bf16_t* Qd = (bf16_t*)smem;
    bf16_t* Ki = (bf16_t*)(smem + 17408);
    bf16_t* Pm = (bf16_t*)(smem + 34816);
    bf16_t* VT = (bf16_t*)(smem + 44032);
    float* st = (float*)(smem + 44032 + 36864);
    stage_vt64(P, m0, C_GLV + h * 256, VT, tid);
    { const int k = tid & 127, tg = tid >> 7;
#pragma unroll 4
      for (int tt = 0; tt < 16; ++tt) { const int t = 16 * tg + tt; const size_t m = m0 + t;
          const float bv = BCUM[m * 512 + h * 128 + k];
          const float qv = bf2f(P[m * NPROJ + C_GLQ + h * 128 + k]), kv = bf2f(P[m * NPROJ + C_GLK + h * 128 + k]);
          Qd[t * 136 + k] = (bf16_t)f2bf(qv * QSCALE * __expf(bv)); Ki[t * 136 + k] = (bf16_t)f2bf(kv * __expf(-bv)); } }
    __syncthreads();
#pragma unroll
    for (int ti = 0; ti < 2; ++ti) { const int tile = 2 * w + ti, tt = tile >> 2, stl = tile & 3; f32x4 acc = {0.f, 0.f, 0.f, 0.f};
        if (stl <= tt) {
#pragma unroll
            for (int ks = 0; ks < 4; ++ks) { const bf16x8 af = *(const bf16x8*)(Qd + (16 * tt + c16) * 136 + 32 * ks + 8 * q), bfr = *(const bf16x8*)(Ki + (16 * stl + c16) * 136 + 32 * ks + 8 * q);
                acc = MFMA16(af, bfr, acc); } }
#pragma unroll
        for (int j = 0; j < 4; ++j) { const int t = 16 * tt + 4 * q + j, s = 16 * stl + c16; Pm[t * 72 + s] = (bf16_t)f2bf((s <= t) ? acc[j] : 0.f); } }
    __syncthreads();
    {
        const int tt = w & 3, vt0 = 8 * (w >> 2);
        bf16x8 pa[2], qa[4];
#pragma unroll
        for (int ks = 0; ks < 2; ++ks) pa[ks] = *(const bf16x8*)(Pm + (16 * tt + c16) * 72 + 32 * ks + 8 * q);
#pragma unroll
        for (int ks = 0; ks < 4; ++ks) qa[ks] = *(const bf16x8*)(Qd + (16 * tt + c16) * 136 + 32 * ks + 8 * q);
        const bf16_t* Sg = SNT + (size_t)(bh * 32 + cn) * 32768;
        f32x4 o[8];
#pragma unroll
        for (int vi = 0; vi < 8; ++vi) { const int vt = vt0 + vi; f32x4 acc = {0.f, 0.f, 0.f, 0.f};
#pragma unroll
            for (int ks = 0; ks < 2; ++ks) { const bf16x8 bfr = *(const bf16x8*)(VT + (16 * vt + c16) * 72 + 32 * ks + 8 * q); acc = MFMA16(pa[ks], bfr, acc); }
#pragma unroll
            for (int ks = 0; ks < 4; ++ks) { const bf16x8 bfr = *(const bf16x8*)(Sg + (size_t)(16 * vt + c16) * 128 + 32 * ks + 8 * q); acc = MFMA16(qa[ks], bfr, acc); }
            o[vi] = acc; }
        float s1[4], s2[4];
#pragma unroll
        for (int j = 0; j < 4; ++j) { float a1 = 0.f, a2 = 0.f;
#pragma unroll
            for (int vi = 0; vi < 8; ++vi) { a1 += o[vi][j]; a2 += o[vi][j] * o[vi][j]; }
#pragma unroll
            for (int x = 1; x < 16; x <<= 1) { a1 += __shfl_xor(a1, x); a2 += __shfl_xor(a2, x); }
            s1[j] = a1; s2[j] = a2; }
        if (c16 == 0) {
#pragma unroll
            for (int j = 0; j < 4; ++j) { st[((w >> 2) * 64 + 16 * tt + 4 * q + j) * 2] = s1[j]; st[((w >> 2) * 64 + 16 * tt + 4 * q + j) * 2 + 1] = s2[j]; } }
        __syncthreads();
#pragma unroll
        for (int j = 0; j < 4; ++j) { const int t = 16 * tt + 4 * q + j;
            const float a1 = st[t * 2] + st[(64 + t) * 2], a2 = st[t * 2 + 1] + st[(64 + t) * 2 + 1];
            const float mean = a1 * (1.f / 256.f), var = a2 * (1.f / 256.f) - mean * mean, rstd = rsqrtf(var + 1e-5f);
            const size_t m = m0 + t;
#pragma unroll
            for (int vi = 0; vi < 8; ++vi) { const int v = 16 * (vt0 + vi) + c16;
                const float r = bf2f(P[m * NPROJ + C_GLR + h * 256 + v]);
                BR[m * NBR + BR_GLA + h * 256 + v] = (bf16_t)f2bf((o[vi][j] - mean) * rstd * gn[h * 256 + v] * siluf_(r)); } }
    }
    __syncthreads();
}

__device__ __forceinline__ void attn_unit(const bf16_t* P, bf16_t* BR, unsigned char* smem, int unit, int tid) {
    const int lane = tid & 63, w = tid >> 6, c16 = lane & 15, q = lane >> 4;
    bf16_t* Ks = (bf16_t*)smem;
    bf16_t* VT = (bf16_t*)(smem + 8704);
    const int bh = unit >> 3, pr = unit & 7, b = bh >> 3, h = bh & 7;
    for (int half = 0; half < 2; ++half) {
        const int qb = half ? 15 - pr : pr;
        const int tq = qb * 128 + 16 * w + c16;
        const size_t mq = (size_t)b * SEQ + tq;
        bf16x8 qf[4];
#pragma unroll
        for (int ks = 0; ks < 4; ++ks) qf[ks] = *(const bf16x8*)(P + mq * NPROJ + C_SBQ + h * 128 + 32 * ks + 8 * q);
        f32x4 o[8];
#pragma unroll
        for (int d = 0; d < 8; ++d) o[d] = (f32x4){0.f, 0.f, 0.f, 0.f};
        float R = 0.f;
        for (int kt = qb * 4 + 3; kt >= 0; --kt) {
            const int key0 = kt * 32;
            __syncthreads();
            { const int key = tid >> 4, d8 = (tid & 15) * 8; const size_t mk = (size_t)b * SEQ + key0 + key;
              const u32x4 kv = *(const u32x4*)(P + mk * NPROJ + C_SBK + h * 128 + d8);
              const u32x4 vv = *(const u32x4*)(P + mk * NPROJ + C_SBV + h * 128 + d8);
              *(u32x4*)(Ks + key * 136 + d8) = kv;
              VT[(d8 + 0) * 40 + key] = (bf16_t)(vv.x & 0xffffu); VT[(d8 + 1) * 40 + key] = (bf16_t)(vv.x >> 16);
              VT[(d8 + 2) * 40 + key] = (bf16_t)(vv.y & 0xffffu); VT[(d8 + 3) * 40 + key] = (bf16_t)(vv.y >> 16);
              VT[(d8 + 4) * 40 + key] = (bf16_t)(vv.z & 0xffffu); VT[(d8 + 5) * 40 + key] = (bf16_t)(vv.z >> 16);
              VT[(d8 + 6) * 40 + key] = (bf16_t)(vv.w & 0xffffu); VT[(d8 + 7) * 40 + key] = (bf16_t)(vv.w >> 16); }
            __syncthreads();
            if (key0 > qb * 128 + 16 * w + 15) continue;
            f32x4 s0 = {0.f, 0.f, 0.f, 0.f}, s1 = {0.f, 0.f, 0.f, 0.f};
#pragma unroll
            for (int ks = 0; ks < 4; ++ks) { const bf16x8 a0 = *(const bf16x8*)(Ks + c16 * 136 + 32 * ks + 8 * q), a1 = *(const bf16x8*)(Ks + (16 + c16) * 136 + 32 * ks + 8 * q);
                s0 = MFMA16(a0, qf[ks], s0); s1 = MFMA16(a1, qf[ks], s1); }
            float z0[4], z1[4], c0[4], c1[4]; bool v0[4], v1[4];
#pragma unroll
            for (int j = 0; j < 4; ++j) { const int sp = key0 + 4 * q + j; z0[j] = s0[j] * QSCALE; z1[j] = s1[j] * QSCALE; v0[j] = sp < tq; v1[j] = (sp + 16) < tq;
                c0[j] = v0[j] ? softplusf_(z0[j]) : 0.f; c1[j] = v1[j] ? softplusf_(z1[j]) : 0.f; }
            c0[2] += c0[3]; c0[1] += c0[2]; c0[0] += c0[1]; c1[2] += c1[3]; c1[1] += c1[2]; c1[0] += c1[1];
            const float T0 = c0[0], T1 = c1[0];
            const float a0x = __shfl_xor(T0, 16), b0x = T0 + a0x, cc0 = __shfl_xor(b0x, 32);
            const float a1x = __shfl_xor(T1, 16), b1x = T1 + a1x, cc1 = __shfl_xor(b1x, 32);
            const float after0 = ((q & 1) ? 0.f : a0x) + ((q & 2) ? 0.f : cc0), after1 = ((q & 1) ? 0.f : a1x) + ((q & 2) ? 0.f : cc1);
            const float all0 = b0x + cc0, all1 = b1x + cc1;
            const float base1 = R + after1, base0 = R + all1 + after0;
            float w0[4], w1[4];
#pragma unroll
            for (int j = 0; j < 4; ++j) { w0[j] = v0[j] ? __expf(z0[j] - (c0[j] + base0)) : 0.f; w1[j] = v1[j] ? __expf(z1[j] - (c1[j] + base1)) : 0.f; }
            R += all0 + all1;
            union { bf16x8 v; unsigned u[4]; } wf;
            wf.u[0] = pk2(w0[0], w0[1]); wf.u[1] = pk2(w0[2], w0[3]); wf.u[2] = pk2(w1[0], w1[1]); wf.u[3] = pk2(w1[2], w1[3]);
#pragma unroll
            for (int dt = 0; dt < 8; ++dt) { const int d = 16 * dt + c16;
                union { bf16x8 v; s16x4 hlf[2]; } af;
                af.hlf[0] = *(const s16x4*)(VT + d * 40 + 4 * q); af.hlf[1] = *(const s16x4*)(VT + d * 40 + 16 + 4 * q);
                o[dt] = MFMA16(af.v, wf.v, o[dt]); }
        }
#pragma unroll
        for (int dt = 0; dt < 8; ++dt) { u32x2 ov; ov.x = pk2(o[dt][0], o[dt][1]); ov.y = pk2(o[dt][2], o[dt][3]);
            *(u32x2*)(BR + mq * NBR + BR_SB + h * 128 + 16 * dt + 4 * q) = ov; }
    }
    __syncthreads();
}


#define XB_TMO      128
#define XB_XCNT(j)  (256  + 64 * (j))
#define XB_XSUB(j)  (1280 + 64 * (j))
#define XB_XGEN(j)  (2304 + 64 * (j))
#define XB_TOP      3328
#define XB_TOPGEN   3392
#define XCD_BAR_WORDS 3456
#define XB_SPIN_CAP (1u << 22)
__device__ __forceinline__ unsigned xb_ld(unsigned* p)              { return __hip_atomic_load(p, __ATOMIC_RELAXED, __HIP_MEMORY_SCOPE_AGENT); }
__device__ __forceinline__ unsigned xb_add(unsigned* p, unsigned v) { return __hip_atomic_fetch_add(p, v, __ATOMIC_RELAXED, __HIP_MEMORY_SCOPE_AGENT); }
__device__ __forceinline__ unsigned xb_xcc_id() { return (unsigned)__builtin_amdgcn_s_getreg((3 << 11) | 20) & 0xFu; }
#define XB_SPIN(cond, bar) do { unsigned _sp = 0; while (cond) { __builtin_amdgcn_s_sleep(1); \
    if ((++_sp & 255u) == 0u) { if (xb_ld(&(bar)[XB_TMO])) break; if (_sp > XB_SPIN_CAP) { atomicAdd(&(bar)[XB_TMO], 1u); break; } } } } while (0)
struct XcdBarrier { unsigned* bar; unsigned x; volatile LAS unsigned* st; };
__device__ __forceinline__ XcdBarrier xcd_barrier_post(unsigned* bar, volatile LAS unsigned* st) {
    XcdBarrier b; b.bar = bar; b.x = xb_xcc_id(); b.st = st;
    if (threadIdx.x == 0) (void)xb_add(&bar[XB_XCNT(b.x)], 1u);
    return b;
}
__device__ __forceinline__ void xcd_barrier_complete(unsigned* bar, unsigned x, unsigned& nloc, unsigned& nx) {
    const unsigned G = gridDim.x * gridDim.y * gridDim.z;
    unsigned sum, cnt, mine, sp = 0u;
    for (;;) {
        sum = 0u; cnt = 0u; mine = 0u;
#pragma unroll
        for (unsigned j = 0; j < 16; ++j) { const unsigned c = xb_ld(&bar[XB_XCNT(j)]); sum += c; cnt += (c > 0u) ? 1u : 0u; mine = (j == x) ? c : mine; }
        if (sum == G) break;
        __builtin_amdgcn_s_sleep(1);
        if ((++sp & 255u) == 0u) { if (xb_ld(&bar[XB_TMO])) break; if (sp > XB_SPIN_CAP) { atomicAdd(&bar[XB_TMO], 1u); break; } }
    }
    nloc = mine > 0u ? mine : 1u; nx = cnt > 0u ? cnt : 1u;
}
__device__ __forceinline__ void xcd_barrier(const XcdBarrier& b) {
    asm volatile("s_waitcnt vmcnt(0)" ::: "memory");
    __syncthreads();
    if (threadIdx.x == 0) {
        unsigned* bar = b.bar;
        __builtin_amdgcn_s_waitcnt(0);
        unsigned nloc = b.st[0], nx = b.st[1];
        if (nloc == 0u) { xcd_barrier_complete(bar, b.x, nloc, nx); b.st[0] = nloc; b.st[1] = nx; }
        const unsigned old = xb_add(&bar[XB_XSUB(b.x)], 1u);
        const unsigned gen = old / nloc;
        if (old + 1u == (gen + 1u) * nloc) {
            __builtin_amdgcn_fence(__ATOMIC_RELEASE, "agent");
            asm volatile("s_waitcnt vmcnt(0)" ::: "memory");
            const unsigned og = xb_add(&bar[XB_TOP], 1u);
            const unsigned tg = og / nx;
            if (og + 1u == (tg + 1u) * nx) xb_add(&bar[XB_TOPGEN], 1u);
            else XB_SPIN(xb_ld(&bar[XB_TOPGEN]) == tg, bar);
            __builtin_amdgcn_fence(__ATOMIC_ACQUIRE, "agent");
            xb_add(&bar[XB_XGEN(b.x)], 1u);
            asm volatile("s_waitcnt vmcnt(0)" ::: "memory");
        } else {
            XB_SPIN(xb_ld(&bar[XB_XGEN(b.x)]) == gen, bar);
            __builtin_amdgcn_fence(__ATOMIC_ACQUIRE, "agent");
            asm volatile("s_waitcnt vmcnt(0)" ::: "memory");
        }
    }
    __syncthreads();
}

constexpr int NPH = 23;
__global__ void __launch_bounds__(512, 2) mk_fwd(Args a) {
    extern __shared__ __attribute__((aligned(16))) unsigned char smem[];
    cg::grid_group grid = cg::this_grid();
    int tid = threadIdx.x, lane = tid & 63, wave = __builtin_amdgcn_readfirstlane(tid >> 6);
    int G = gridDim.x, bid = blockIdx.x, gw = bid * 8 + wave, ngw = G * 8;
    LAS unsigned char* lds = (LAS unsigned char*)smem;
    unsigned char* ws = a.ws;
    float* MOD = (float*)(ws + WS_MOD);
    bf16_t* H = (bf16_t*)(ws + WS_H); bf16_t* PROJ = (bf16_t*)(ws + WS_PROJ); bf16_t* ACT = (bf16_t*)(ws + WS_ACT);
    bf16_t* BR = (bf16_t*)(ws + WS_BR); float* Y = (float*)(ws + WS_Y); bf16_t* MBF = (bf16_t*)(ws + WS_MB); float* X1 = (float*)(ws + WS_X1);
    float* SLOC = (float*)(ws + WS_SLOC); bf16_t* SPREV = (bf16_t*)(ws + WS_SPREV); float* BCUM = (float*)(ws + WS_BCUM);
    float* AEND = (float*)(ws + WS_AEND); float* LCT = (float*)(ws + WS_LCT); bf16_t* SNT = (bf16_t*)(ws + WS_SNT);
    const int lo = a.ph_lo, hi = a.ph_hi;
    volatile LAS unsigned* xst = (volatile LAS unsigned*)(lds + LDS_BYTES - 64);
    if (tid == 0) { xst[0] = 0u; xst[1] = 0u; }
    __syncthreads();
    XcdBarrier xbar = xcd_barrier_post((unsigned*)(ws + WS_CTL), xst);
#define IN(k) (lo <= (k) && (k) < hi)
#define SEAM(k) do { if (IN(k) && IN((k) + 1)) { if ((k) == 0) grid.sync(); else xcd_barrier(xbar); } FRESH(); } while (0)
#define FRESH() do { tid = threadIdx.x; asm volatile("" : "+v"(tid)); lane = tid & 63; wave = __builtin_amdgcn_readfirstlane(tid >> 6); bid = blockIdx.x; asm volatile("" : "+s"(bid)); G = gridDim.x; asm volatile("" : "+s"(G)); gw = bid * 8 + wave; ngw = G * 8; } while (0)

    if (IN(0)) {
        {
            float* sc = (float*)smem;
            for (int i = tid; i < NB * DM; i += 512) sc[i] = siluf_(a.in[I_C][i]);
            __syncthreads();
            for (int it = bid; it < 384; it += G) p0_adaln_item(a, smem, it, tid);
            __syncthreads();
        }
        for (int it = bid; it < 128; it += G) p0_s5pre_item(a, smem, it, tid);
        __syncthreads();
        p0_transposes(a, smem, gw, ngw, wave, lane);
        __syncthreads();
    }
    SEAM(0);

    for (int l = 0; l < 2; ++l) {
        const int pb = 1 + 11 * l;
        const unsigned char* wl = ws + WS_W + (size_t)l * W_LAYER;
        const unsigned char* s5w = ws + WS_S5M + (size_t)l * S5_LAYER;
        const float* modl = MOD + (size_t)l * 4 * 12288;
        const float* xin = l == 0 ? a.in[I_X] : a.out;
        if (IN(pb + 0) && l == 0) ln_phase(xin, nullptr, nullptr, nullptr, modl + 2048, modl, H, gw, ngw, lane);
        if (l == 0) SEAM(pb + 0);
        if (IN(pb + 1)) { pg8::Gemm g{H, (const bf16_t*)(wl + WO_WIN), DM, DM, DM}; pg8::StaticOrder S; S.init(MTOK, NPROJ, G, bid);
            pg8::EpiBf16 E{PROJ, NPROJ}; pg8::gemm_phase(lds, g, S, E, tid); }
        SEAM(pb + 1);
        if (IN(pb + 2)) {
            for (int u = bid; u < 256; u += G) attn_unit(PROJ, BR, smem, u, tid);
            for (int it = bid; it < 512; it += G) glaa_item(PROJ, a.in[I_GLAWG] + (size_t)l * 16 * 512, a.in[I_GLABG] + l * 512, BCUM, AEND, LCT, smem, it, tid);
            for (int it = gw; it < 2048; it += ngw) s5a_item(PROJ, (const bf16_t*)(s5w + S5O_MIN), SLOC, it, lane);
            for (int it = bid; it < 2048; it += G) conv_item(PROJ, BR, a.in[I_CONVW] + (size_t)l * 3 * 1024, it, tid);
        }
        SEAM(pb + 2);
        if (IN(pb + 3)) {
            for (int it = bid; it < 32 + 1024; it += G) {
                if (it < 32) { const int idx = it * 512 + tid, b = idx >> 12, g = (idx >> 6) & 63, p = idx & 63;
                    const float2 ab = ((const float2*)(s5w + S5O_A16))[g * 64 + p]; float sr = 0.f, si = 0.f;
#pragma unroll 4
                    for (int c = 0; c < 128; ++c) { const size_t base = ((size_t)(b * 128 + c) * 64 + g) * 128;
                        SPREV[base + p] = (bf16_t)f2bf(sr); SPREV[base + 64 + p] = (bf16_t)f2bf(si);
                        const float lr = SLOC[base + p], li = SLOC[base + 64 + p];
                        const float nr = ab.x * sr - ab.y * si + lr, ni = ab.x * si + ab.y * sr + li; sr = nr; si = ni; } }
                else { const int idx = (it - 32) * 512 + tid, bh = idx >> 15, e = idx & 32767, k = e & 127; float s = 0.f;
#pragma unroll 4
                    for (int cn = 0; cn < 32; ++cn) { const size_t base = (size_t)(bh * 32 + cn);
                        SNT[base * 32768 + e] = (bf16_t)f2bf(s);
                        s = AEND[base * 128 + k] * s + LCT[base * 32768 + e]; } }
            }
        }
        SEAM(pb + 3);
        if (IN(pb + 4)) {
            for (int it = bid; it < 512; it += G) glac_item(PROJ, BCUM, SNT, a.in[I_GLANG] + l * 1024, BR, smem, it, tid);
            for (int it = gw; it < 2048; it += ngw) s5c_item(PROJ, (const bf16_t*)(s5w + S5O_MROW), SPREV, a.in[I_S5D] + l * 1024, BR, it, lane);
        }
        SEAM(pb + 4);
        if (IN(pb + 5)) { pg8::Gemm g{BR, (const bf16_t*)(wl + WO_WBR), NBR, 1024, 1024}; pg8::BranchOrder S{G, bid};
            pg8::EpiBranch E{PROJ, Y, MBF}; pg8::gemm_phase(lds, g, S, E, tid); }
        SEAM(pb + 5);
        if (IN(pb + 6)) { pg8::Gemm g{MBF, (const bf16_t*)(wl + WO_WO), DM, DM, DM}; pg8::StaticOrder S; S.init(MTOK, DM, G, bid);
            pg8::EpiResid E{xin, modl + 2 * 2048, Y}; pg8::gemm_phase(lds, g, S, E, tid); }
        SEAM(pb + 6);
        if (IN(pb + 7)) ln_phase(Y, a.in[I_LN1G] + l * DM, a.in[I_LN1B] + l * DM, X1, modl + 4 * 2048, modl + 3 * 2048, H, gw, ngw, lane);
        SEAM(pb + 7);
        if (IN(pb + 8)) { pg8::Gemm g{H, (const bf16_t*)(wl + WO_WGU), DM, DM, DM}; pg8::StaticOrder S; S.init(MTOK, NGU, G, bid);
            pg8::EpiGateUp E{ACT}; pg8::gemm_phase(lds, g, S, E, tid); }
        SEAM(pb + 8);
        if (IN(pb + 9)) { pg8::Gemm g{ACT, (const bf16_t*)(wl + WO_WD), DFF, DFF, DFF}; pg8::StaticOrder S; S.init(MTOK, DM, G, bid);
            pg8::EpiResid E{X1, modl + 5 * 2048, Y}; pg8::gemm_phase(lds, g, S, E, tid); }
        SEAM(pb + 9);
        if (IN(pb + 10)) { const float* modn = MOD + (size_t)(l + 1) * 4 * 12288;
            ln_phase(Y, a.in[I_LN2G] + l * DM, a.in[I_LN2B] + l * DM, a.out, l == 0 ? modn + 2048 : nullptr, l == 0 ? modn : nullptr, H, gw, ngw, lane); }
        if (l == 0) SEAM(pb + 10);
    }
#undef IN
#undef SEAM
}

#ifndef MK_SPLIT
#define MK_SPLIT 0
#endif
extern "C" void kernel_launch(void* const* d_in, const int* in_sizes, int n_in, void* d_out, int out_size, void* d_ws, size_t ws_size, hipStream_t stream) {
    static int grid = 0;
    if (grid == 0) {
        if (n_in != 30 || ws_size < WS_END) { fprintf(stderr, "kernel_launch: unexpected n_in %d or ws_size %zu (< %zu)\n", n_in, ws_size, (size_t)WS_END); grid = -1; return; }
        int dev = 0, cus = 0, per_cu = 0;
        hipGetDevice(&dev); hipDeviceGetAttribute(&cus, hipDeviceAttributeMultiprocessorCount, dev);
        if (hipFuncSetAttribute((const void*)mk_fwd, hipFuncAttributeMaxDynamicSharedMemorySize, LDS_BYTES) != hipSuccess) { fprintf(stderr, "kernel_launch: hipFuncSetAttribute failed\n"); grid = -1; return; }
        if (hipOccupancyMaxActiveBlocksPerMultiprocessor(&per_cu, (const void*)mk_fwd, 512, LDS_BYTES) != hipSuccess || per_cu < 1) { fprintf(stderr, "kernel_launch: occupancy query says %d\n", per_cu); per_cu = 1; }
        (void)hipGetLastError();
        grid = cus > 256 ? 256 : cus;
    }
    if (grid < 0) return;
    if (hipMemsetAsync((char*)d_ws + WS_CTL, 0, CTL_BYTES, stream) != hipSuccess) { fprintf(stderr, "memset failed\n"); return; }
    Args a{};
    for (int i = 0; i < 30; ++i) a.in[i] = (const float*)d_in[i];
    a.out = (float*)d_out; a.ws = (unsigned char*)d_ws;
#if MK_SPLIT
    for (int ph = 0; ph < NPH; ++ph) { a.ph_lo = ph; a.ph_hi = ph + 1; hipLaunchKernelGGL(mk_fwd, dim3(grid), dim3(512), LDS_BYTES, stream, a); }
#else
    a.ph_lo = 0; a.ph_hi = NPH;
    void* args[] = {&a};
    hipError_t e = hipLaunchCooperativeKernel((const void*)mk_fwd, dim3(grid), dim3(512), args, LDS_BYTES, stream);
    if (e != hipSuccess) fprintf(stderr, "cooperative launch failed: %s (grid %d)\n", hipGetErrorString(e), grid);
#endif
}
```

```cpp
#include <hip/hip_runtime.h>
#include <hip/hip_cooperative_groups.h>
#include <cstdio>
#include <cstdint>
namespace cg = cooperative_groups;

#define LAS __attribute__((address_space(3)))
typedef unsigned short bf16_t;
typedef short bf16x8 __attribute__((ext_vector_type(8)));
typedef short s16x4 __attribute__((ext_vector_type(4)));
typedef float f32x4 __attribute__((ext_vector_type(4)));
typedef unsigned u32x4 __attribute__((ext_vector_type(4)));
typedef unsigned u32x2 __attribute__((ext_vector_type(2)));

constexpr int DM = 2048, NB = 4, SEQ = 2048, MTOK = NB * SEQ, NPROJ = 18688, NIN = 18448, DFF = 5632, NGU = 2 * DFF;
constexpr int C_CVB = 0, C_CVC = 1024, C_CVX = 2048, C_S5U = 3072, C_SBQ = 4096, C_SBK = 5120, C_SBV = 6144, C_GLQ = 7168,
              C_GLK = 7680, C_GLV = 8192, C_GLR = 9216, C_GCONV = 10240, C_GS5 = 12288, C_GSB = 14336, C_GGLA = 16384, C_GLLR = 18432;
constexpr int BR_CONV = 0, BR_S5 = 1024, BR_SB = 2048, BR_GLA = 3072, NBR = 4096;
constexpr float ALPHA = 1.41421356237f;
constexpr float QSCALE = 0.08838834764831845f;

constexpr size_t MiB = 1u << 20;
constexpr size_t W_LAYER = 167 * MiB;
constexpr size_t WO_WIN = 0, WO_WBR = 73 * MiB, WO_WO = 93 * MiB, WO_WGU = 101 * MiB, WO_WD = 145 * MiB;
constexpr size_t WS_W = 0;
constexpr size_t WS_S5M = 334 * MiB;
constexpr size_t S5_LAYER = 17 * MiB, S5O_MROW = 0, S5O_MIN = 12 * MiB, S5O_A16 = 16 * MiB;
constexpr size_t WS_MOD = 368 * MiB;
constexpr size_t WS_H = 369 * MiB;
constexpr size_t WS_PROJ = 401 * MiB;
constexpr size_t WS_ACT = WS_PROJ;
constexpr size_t WS_BR = 693 * MiB;
constexpr size_t WS_Y = 757 * MiB;
constexpr size_t WS_MB = 821 * MiB;
constexpr size_t WS_X1 = 853 * MiB;
constexpr size_t WS_SLOC = 917 * MiB;
constexpr size_t WS_SPREV = 933 * MiB;
constexpr size_t WS_BCUM = 941 * MiB;
constexpr size_t WS_AEND = 957 * MiB;
constexpr size_t WS_LCT = 958 * MiB;
constexpr size_t WS_SNT = 1022 * MiB;
constexpr size_t WS_CTL = 1054 * MiB;
constexpr size_t CTL_BYTES = 16384;
constexpr size_t WS_END = 1055 * MiB;

constexpr int LDS_BYTES = 147456;

__device__ __forceinline__ float bf2f(unsigned u) { return __builtin_bit_cast(float, u << 16); }
__device__ __forceinline__ unsigned f2bf(float f) { unsigned u = __builtin_bit_cast(unsigned, f); return (u + 0x7fffu + ((u >> 16) & 1u)) >> 16; }
__device__ __forceinline__ unsigned pk2(float lo, float hi) { return f2bf(lo) | (f2bf(hi) << 16); }
__device__ __forceinline__ float lo16(unsigned w) { return __builtin_bit_cast(float, w << 16); }
__device__ __forceinline__ float hi16(unsigned w) { return __builtin_bit_cast(float, w & 0xffff0000u); }
__device__ __forceinline__ float sigm(float x) { return 1.f / (1.f + __expf(-x)); }
__device__ __forceinline__ float siluf_(float x) { return x / (1.f + __expf(-x)); }
__device__ __forceinline__ float gelu_tanh(float x) { float u = 0.7978845608028654f * (x + 0.044715f * x * x * x); float t = 1.f - 2.f / (1.f + __expf(2.f * u)); return 0.5f * x * (1.f + t); }
__device__ __forceinline__ float softplusf_(float z) { return fmaxf(z, 0.f) + __logf(1.f + __expf(-fabsf(z))); }
__device__ __forceinline__ float wave_sum(float v) {
#pragma unroll
    for (int o = 1; o < 64; o <<= 1) v += __shfl_xor(v, o);
    return v;
}
#define MFMA16(a, b, c) __builtin_amdgcn_mfma_f32_16x16x32_bf16((a), (b), (c), 0, 0, 0)

namespace pg8 {
constexpr int BM = 256, BK = 64, HALF = 128, HTB = HALF * BK * 2, NXCD = 8, WGM = 8;
__host__ __device__ __forceinline__ int lds_byte(int r, int c) { const int st = (r >> 4) * 2 + (c >> 5), rr = r & 15, cc = c & 31, ob = rr * 64 + cc * 2; return st * 1024 + (ob ^ (((ob >> 9) & 1) << 5)); }
__host__ __device__ __forceinline__ void stage_rc(int b, int& R, int& C) { const int st = b / 1024, sb = b % 1024, swz = sb ^ (((sb >> 9) & 1) << 5); R = (st >> 1) * 16 + swz / 64; C = (st & 1) * 32 + (swz % 64) / 2; }
__host__ __device__ __forceinline__ int perm32(int rho) { const int n = rho >> 4, i = rho & 15; return 8 * (i >> 2) + 4 * n + (i & 3); }

struct Unit { int pm, pn, acol, mode; };
struct Gemm { const bf16_t* A; const bf16_t* Bt; int lda, ldb, K; };

struct StaticOrder {
    int nM, nN, nwg, G, c;
    __device__ void init(int M, int N, int G_, int c_) { nM = M / BM; nN = N / BM; nwg = nM * nN; G = G_; c = c_; }
    __device__ bool next(int i, Unit& u) const {
        const long L = (long)i * G + c; if (L >= nwg) return false;
        int wgid = (int)L; { const int q = nwg / NXCD, r = nwg % NXCD, xcd = wgid % NXCD, off = wgid / NXCD; wgid = (xcd < r ? xcd * (q + 1) : r * (q + 1) + (xcd - r) * q) + off; }
        const int nig = WGM * nN, gid = wgid / nig, fm = gid * WGM, gsz = (nM - fm) < WGM ? (nM - fm) : WGM;
        u.pm = fm + ((wgid % nig) % gsz); u.pn = (wgid % nig) / gsz; u.acol = 0; u.mode = 0; return true;
    }
};
struct BranchOrder {
    int G, c;
    __device__ bool next(int i, Unit& u) const {
        const int L = (i / 5) * G + c; if (L >= 256) return false;
        const int sub = i % 5, pn8 = L & 7; u.pm = L >> 3;
        if (sub == 0) { u.pn = pn8; u.acol = BR_CONV; u.mode = 0; }
        else if (sub == 1) { u.pn = 8 + pn8; u.acol = BR_SB; u.mode = 1; }
        else if (sub == 2) { u.pn = 16 + pn8; u.acol = BR_GLA; u.mode = 2; }
        else { u.pn = 24 + 2 * pn8 + (sub - 3); u.acol = BR_S5; u.mode = 3; }
        return true;
    }
};

template <class Epi, class Sched>
__device__ __forceinline__ void gemm_phase(LAS unsigned char* lds, const Gemm g, const Sched& S, const Epi& E, int tid) {
    const int wid = __builtin_amdgcn_readfirstlane(tid >> 6), lane = tid & 63, wr = wid >> 2, wc = wid & 3, fr = lane & 15, fq = lane >> 4;
    const int K = g.K, nt = K / BK;
    unsigned voffA[2], voffB[2];
#pragma unroll
    for (int i = 0; i < 2; ++i) { int R, C; stage_rc(tid * 16 + i * 8192, R, C); const int Rb = (R & ~31) + perm32(R & 31);
        voffA[i] = (unsigned)(R * g.lda + C) * 2u; voffB[i] = (unsigned)(Rb * g.ldb + C) * 2u; }
    const size_t kstep = (size_t)(BK * 2);
    const size_t hstepA = (size_t)HALF * g.lda * 2, hstepB = (size_t)HALF * g.ldb * 2;
    const size_t tstepA = 2 * hstepA, tstepB = 2 * hstepB;
    const unsigned ldsw = (unsigned)wid * 1024u;
    const int aoff = lds_byte(wr * 64 + fr, fq * 8), boff = lds_byte(wc * 32 + fr, fq * 8);
#define PG8_SA(b, h) (((b) * 2 + (h)) * HTB)
#define PG8_SB(b, h) ((4 + (b) * 2 + (h)) * HTB)
#define PG8_STAGE(bufoff, gbase, voff) do { _Pragma("unroll") for (int _i = 0; _i < 2; ++_i) \
        __builtin_amdgcn_global_load_lds((const unsigned*)((const char*)(gbase) + (voff)[_i]), (LAS unsigned*)(lds + (bufoff) + ldsw + _i * 8192), 16, 0, 0); } while (0)
#define PG8_LDA(dst, b, h) do { _Pragma("unroll") for (int m = 0; m < 4; ++m) _Pragma("unroll") for (int k = 0; k < 2; ++k) dst[m][k] = *(const LAS bf16x8*)(lds + PG8_SA(b, h) + aoff + m * 2048 + k * 1024); } while (0)
#define PG8_LDB(dst, b, h) do { _Pragma("unroll") for (int n = 0; n < 2; ++n) _Pragma("unroll") for (int k = 0; k < 2; ++k) dst[n][k] = *(const LAS bf16x8*)(lds + PG8_SB(b, h) + boff + n * 2048 + k * 1024); } while (0)
#define PG8_MMA(ai, bj, At, Bt) do { __builtin_amdgcn_s_setprio(1); _Pragma("unroll") for (int m = 0; m < 4; ++m) _Pragma("unroll") for (int n = 0; n < 2; ++n) _Pragma("unroll") for (int k = 0; k < 2; ++k) \
        acc[ai][bj][m][n] = __builtin_amdgcn_mfma_f32_16x16x32_bf16(Bt[n][k], At[m][k], acc[ai][bj][m][n], 0, 0, 0); __builtin_amdgcn_s_setprio(0); } while (0)
#define PG8_WAIT_V(n) asm volatile("s_waitcnt vmcnt(" #n ")" ::: "memory")
#define PG8_WAIT_L(n) asm volatile("s_waitcnt lgkmcnt(" #n ")" ::: "memory")
#define PG8_BAR __builtin_amdgcn_s_barrier()
#define PG8_SCHED __builtin_amdgcn_sched_barrier(0)
    Unit cur, nxt; int ui = 0;
    if (!S.next(0, cur)) return;
    f32x4 acc[2][2][4][2];
#pragma unroll
    for (int a = 0; a < 2; ++a)
#pragma unroll
        for (int b = 0; b < 2; ++b)
#pragma unroll
            for (int m = 0; m < 4; ++m)
#pragma unroll
                for (int n = 0; n < 2; ++n) acc[a][b][m][n] = (f32x4){0.f, 0.f, 0.f, 0.f};
    bf16x8 At[4][2], B0[2][2], B1[2][2];
    const char* cA = (const char*)g.A + (size_t)cur.pm * tstepA + (size_t)cur.acol * 2; const char* cB = (const char*)g.Bt + (size_t)cur.pn * tstepB;
    PG8_STAGE(PG8_SB(0, 0), cB, voffB); PG8_STAGE(PG8_SB(0, 1), cB + hstepB, voffB); PG8_STAGE(PG8_SA(0, 0), cA, voffA); PG8_STAGE(PG8_SA(0, 1), cA + hstepA, voffA);
    if (wr == 1) PG8_BAR;
    PG8_WAIT_V(2); PG8_BAR;
    PG8_STAGE(PG8_SB(1, 0), cB + kstep, voffB); PG8_STAGE(PG8_SA(1, 0), cA + kstep, voffA); PG8_STAGE(PG8_SB(1, 1), cB + hstepB + kstep, voffB);
    PG8_WAIT_V(6); PG8_BAR;
    for (;;) {
        const bool has_next = S.next(ui + 1, nxt);
        const char* nA = has_next ? (const char*)g.A + (size_t)nxt.pm * tstepA + (size_t)nxt.acol * 2 : cA; const char* nB = has_next ? (const char*)g.Bt + (size_t)nxt.pn * tstepB : cB;
        for (int t = 0; t < nt; t += 2) {
            const bool last = (t == nt - 2);
            const char* a1 = cA + (size_t)(t + 1) * kstep;
            const char* a2 = last ? nA : cA + (size_t)(t + 2) * kstep; const char* b2 = last ? nB : cB + (size_t)(t + 2) * kstep;
            const char* a3 = a2 + kstep; const char* b3 = b2 + kstep;
            PG8_LDB(B0, 0, 0); PG8_LDB(B1, 0, 1); PG8_SCHED; PG8_LDA(At, 0, 0); PG8_STAGE(PG8_SA(1, 1), a1 + hstepA, voffA);
            PG8_WAIT_V(8); PG8_WAIT_L(0); PG8_BAR; PG8_MMA(0, 0, At, B0); PG8_MMA(0, 1, At, B1); PG8_BAR; PG8_SCHED;
            PG8_LDA(At, 0, 1); PG8_STAGE(PG8_SB(0, 0), b2, voffB); PG8_STAGE(PG8_SB(0, 1), b2 + hstepB, voffB); PG8_STAGE(PG8_SA(0, 0), a2, voffA);
            PG8_WAIT_V(8); PG8_WAIT_L(0); PG8_BAR; PG8_MMA(1, 0, At, B0); PG8_MMA(1, 1, At, B1); PG8_BAR; PG8_SCHED;
            PG8_LDB(B0, 1, 0); PG8_LDB(B1, 1, 1); PG8_SCHED; PG8_LDA(At, 1, 0); PG8_STAGE(PG8_SA(0, 1), a2 + hstepA, voffA);
            PG8_WAIT_V(8); PG8_WAIT_L(0); PG8_BAR; PG8_MMA(0, 0, At, B0); PG8_MMA(0, 1, At, B1); PG8_BAR; PG8_SCHED;
            PG8_LDA(At, 1, 1); PG8_STAGE(PG8_SB(1, 0), b3, voffB); PG8_STAGE(PG8_SB(1, 1), b3 + hstepB, voffB); PG8_STAGE(PG8_SA(1, 0), a3, voffA);
            PG8_WAIT_V(8); PG8_WAIT_L(0); PG8_BAR; PG8_MMA(1, 0, At, B0); PG8_MMA(1, 1, At, B1); PG8_BAR; PG8_SCHED;
        }
        E(acc, cur, wr, wc, fr, fq);
        if (!has_next) break;
#pragma unroll
        for (int a = 0; a < 2; ++a)
#pragma unroll
            for (int b = 0; b < 2; ++b)
#pragma unroll
                for (int m = 0; m < 4; ++m)
#pragma unroll
                    for (int n = 0; n < 2; ++n) acc[a][b][m][n] = (f32x4){0.f, 0.f, 0.f, 0.f};
        cur = nxt; cA = nA; cB = nB; ++ui;
    }
    PG8_WAIT_V(0);
    if (wr == 0) PG8_BAR;
    PG8_BAR;
#undef PG8_SA
#undef PG8_SB
#undef PG8_STAGE
#undef PG8_LDA
#undef PG8_LDB
#undef PG8_MMA
#undef PG8_WAIT_V
#undef PG8_WAIT_L
#undef PG8_BAR
#undef PG8_SCHED
}

struct EpiBf16 {
    bf16_t* O; int ldc;
    __device__ __forceinline__ void operator()(const f32x4 (&acc)[2][2][4][2], const Unit& u, int wr, int wc, int fr, int fq) const {
        const int row0 = u.pm * BM + wr * 64 + fr, col0 = u.pn * BM + wc * 32 + 8 * fq;
#pragma unroll
        for (int ai = 0; ai < 2; ++ai)
#pragma unroll
            for (int m = 0; m < 4; ++m) { bf16_t* rowp = O + (size_t)(row0 + ai * HALF + m * 16) * ldc + col0;
#pragma unroll
                for (int bj = 0; bj < 2; ++bj) { const f32x4 v0 = acc[ai][bj][m][0], v1 = acc[ai][bj][m][1];
                    u32x4 w; w.x = pk2(v0[0], v0[1]); w.y = pk2(v0[2], v0[3]); w.z = pk2(v1[0], v1[1]); w.w = pk2(v1[2], v1[3]);
                    *(u32x4*)(rowp + bj * HALF) = w; } }
    }
};
struct EpiGateUp {
    bf16_t* O;
    __device__ __forceinline__ void operator()(const f32x4 (&acc)[2][2][4][2], const Unit& u, int wr, int wc, int fr, int fq) const {
        const int row0 = u.pm * BM + wr * 64 + fr, col0 = u.pn * HALF + wc * 32 + 8 * fq;
#pragma unroll
        for (int ai = 0; ai < 2; ++ai)
#pragma unroll
            for (int m = 0; m < 4; ++m) { bf16_t* rowp = O + (size_t)(row0 + ai * HALF + m * 16) * DFF + col0;
                float r[8];
#pragma unroll
                for (int n = 0; n < 2; ++n)
#pragma unroll
                    for (int i = 0; i < 4; ++i) r[n * 4 + i] = siluf_(acc[ai][0][m][n][i]) * acc[ai][1][m][n][i];
                u32x4 w; w.x = pk2(r[0], r[1]); w.y = pk2(r[2], r[3]); w.z = pk2(r[4], r[5]); w.w = pk2(r[6], r[7]);
                *(u32x4*)rowp = w; }
    }
};
struct EpiResid {
    const float* X; const float* gate; float* Y;
    __device__ __forceinline__ void operator()(const f32x4 (&acc)[2][2][4][2], const Unit& u, int wr, int wc, int fr, int fq) const {
        const int row0 = u.pm * BM + wr * 64 + fr, col0 = u.pn * BM + wc * 32 + 8 * fq;
        const float* gp = gate + (size_t)(u.pm >> 3) * 12288 + col0;
#pragma unroll
        for (int bj = 0; bj < 2; ++bj) {
            const f32x4 g0 = *(const f32x4*)(gp + bj * HALF), g1 = *(const f32x4*)(gp + bj * HALF + 4);
#pragma unroll
            for (int ai = 0; ai < 2; ++ai)
#pragma unroll
                for (int m = 0; m < 4; ++m) { const size_t off = (size_t)(row0 + ai * HALF + m * 16) * DM + col0 + bj * HALF;
                    const f32x4 x0 = *(const f32x4*)(X + off), x1 = *(const f32x4*)(X + off + 4);
                    *(f32x4*)(Y + off) = x0 * ALPHA + g0 * acc[ai][bj][m][0];
                    *(f32x4*)(Y + off + 4) = x1 * ALPHA + g1 * acc[ai][bj][m][1]; }
        }
    }
};
struct EpiBranch {
    const bf16_t* P; float* MG; bf16_t* MBF;
    __device__ __forceinline__ void operator()(const f32x4 (&acc)[2][2][4][2], const Unit& u, int wr, int wc, int fr, int fq) const {
        const int row0 = u.pm * BM + wr * 64 + fr;
        if (u.mode < 3) {
            const int col0 = u.pn * BM - u.mode * 2048 + wc * 32 + 8 * fq;
            const int gcol = (u.mode == 0 ? C_GCONV : (u.mode == 1 ? C_GSB : C_GGLA));
#pragma unroll
            for (int ai = 0; ai < 2; ++ai)
#pragma unroll
                for (int m = 0; m < 4; ++m) { const int row = row0 + ai * HALF + m * 16;
#pragma unroll
                    for (int bj = 0; bj < 2; ++bj) { const int c = col0 + bj * HALF;
                        const u32x4 gw = *(const u32x4*)(P + (size_t)row * NPROJ + gcol + c);
                        f32x4 r0, r1;
                        r0[0] = sigm(lo16(gw.x)) * acc[ai][bj][m][0][0]; r0[1] = sigm(hi16(gw.x)) * acc[ai][bj][m][0][1];
                        r0[2] = sigm(lo16(gw.y)) * acc[ai][bj][m][0][2]; r0[3] = sigm(hi16(gw.y)) * acc[ai][bj][m][0][3];
                        r1[0] = sigm(lo16(gw.z)) * acc[ai][bj][m][1][0]; r1[1] = sigm(hi16(gw.z)) * acc[ai][bj][m][1][1];
                        r1[2] = sigm(lo16(gw.w)) * acc[ai][bj][m][1][2]; r1[3] = sigm(hi16(gw.w)) * acc[ai][bj][m][1][3];
                        float* mp = MG + (size_t)row * DM + c;
                        if (u.mode != 0) { r0 += *(const f32x4*)mp; r1 += *(const f32x4*)(mp + 4); }
                        *(f32x4*)mp = r0; *(f32x4*)(mp + 4) = r1; } }
        } else {
            const int col0 = (u.pn - 24) * HALF + wc * 32 + 8 * fq;
#pragma unroll
            for (int ai = 0; ai < 2; ++ai)
#pragma unroll
                for (int m = 0; m < 4; ++m) { const int row = row0 + ai * HALF + m * 16;
                    const u32x4 gw = *(const u32x4*)(P + (size_t)row * NPROJ + C_GS5 + col0);
                    const float* mp = MG + (size_t)row * DM + col0;
                    const f32x4 m0 = *(const f32x4*)mp, m1 = *(const f32x4*)(mp + 4);
                    float r[8];
                    r[0] = m0[0] + sigm(lo16(gw.x)) * acc[ai][0][m][0][0] * sigm(acc[ai][1][m][0][0]);
                    r[1] = m0[1] + sigm(hi16(gw.x)) * acc[ai][0][m][0][1] * sigm(acc[ai][1][m][0][1]);
                    r[2] = m0[2] + sigm(lo16(gw.y)) * acc[ai][0][m][0][2] * sigm(acc[ai][1][m][0][2]);
                    r[3] = m0[3] + sigm(hi16(gw.y)) * acc[ai][0][m][0][3] * sigm(acc[ai][1][m][0][3]);
                    r[4] = m1[0] + sigm(lo16(gw.z)) * acc[ai][0][m][1][0] * sigm(acc[ai][1][m][1][0]);
                    r[5] = m1[1] + sigm(hi16(gw.z)) * acc[ai][0][m][1][1] * sigm(acc[ai][1][m][1][1]);
                    r[6] = m1[2] + sigm(lo16(gw.w)) * acc[ai][0][m][1][2] * sigm(acc[ai][1][m][1][2]);
                    r[7] = m1[3] + sigm(hi16(gw.w)) * acc[ai][0][m][1][3] * sigm(acc[ai][1][m][1][3]);
                    u32x4 w; w.x = pk2(r[0], r[1]); w.y = pk2(r[2], r[3]); w.z = pk2(r[4], r[5]); w.w = pk2(r[6], r[7]);
                    *(u32x4*)(MBF + (size_t)row * DM + col0) = w; }
        }
    }
};
}

struct Args { const float* in[30]; float* out; unsigned char* ws; int ph_lo, ph_hi; };
enum { I_X = 0, I_C, I_ADAW, I_ADAB, I_WIN, I_CONVW, I_WCO, I_LRE, I_LIM, I_BRE, I_BIM, I_CRE, I_CIM, I_S5D, I_LOGDT, I_WS5V, I_WS5G, I_WSB,
       I_GLAWG, I_GLABG, I_GLANG, I_WGLA, I_WO, I_LN1G, I_LN1B, I_FFG, I_FFU, I_FFD, I_LN2G, I_LN2B };

__device__ __forceinline__ void tr_item(const float* srcp, int ld, int k0, bf16_t* WT, int Kd, int n0, float* scr, int lane) {
    const int r4 = lane >> 4, n4 = (lane & 15) * 4;
    f32x4 v[16];
#pragma unroll
    for (int i = 0; i < 16; ++i) v[i] = srcp ? *(const f32x4*)(srcp + (size_t)(k0 + 4 * i + r4) * ld) : (f32x4){0.f, 0.f, 0.f, 0.f};
#pragma unroll
    for (int i = 0; i < 16; ++i) { float* d = scr + (4 * i + r4) * 65 + n4; d[0] = v[i][0]; d[1] = v[i][1]; d[2] = v[i][2]; d[3] = v[i][3]; }
    __builtin_amdgcn_s_waitcnt(0); asm volatile("" ::: "memory");
    const int c = lane & 7;
#pragma unroll
    for (int j = 0; j < 8; ++j) { const int n = (lane >> 3) + 8 * j; const float* s = scr + (8 * c) * 65 + n;
        u32x4 o; o.x = pk2(s[0 * 65], s[1 * 65]); o.y = pk2(s[2 * 65], s[3 * 65]); o.z = pk2(s[4 * 65], s[5 * 65]); o.w = pk2(s[6 * 65], s[7 * 65]);
        *(u32x4*)(WT + (size_t)(n0 + n) * Kd + k0 + 8 * c) = o; }
    __builtin_amdgcn_s_waitcnt(0); asm volatile("" ::: "memory");
}

__device__ __forceinline__ void p0_transposes(const Args& a, unsigned char* smem, int gw, int ngw, int wave, int lane) {
    float* scr = (float*)(smem + wave * 16640);
    constexpr int C0 = 32 * 292, C1 = 16 * 160, C2 = 32 * 32, C3 = 32 * 176, C4 = 88 * 32, CL = C0 + C1 + C2 + C3 + C4;
    for (int it = gw; it < 2 * CL; it += ngw) {
        const int l = it / CL; int r = it % CL;
        unsigned char* wl = a.ws + WS_W + (size_t)l * W_LAYER;
        const int nl = (lane & 15) * 4;
        if (r < C0) { const int kb = r / 292, nb = r % 292, j = nb * 64 + nl;
            const float* base = a.in[I_WIN] + (size_t)l * DM * NIN;
            const float* sp = j < 10240 ? base + j : (j < 18432 ? base + j + 16 : (j < 18448 ? base + (j - 8192) : nullptr));
            tr_item(sp, NIN, kb * 64, (bf16_t*)(wl + WO_WIN), DM, nb * 64, scr, lane); continue; }
        r -= C0;
        if (r < C1) { const int kb = r / 160, nb = r % 160, j = nb * 64 + nl; const float* sp;
            if (j < 2048) sp = a.in[I_WCO] + (size_t)l * 1024 * DM + j;
            else if (j < 4096) sp = a.in[I_WSB] + (size_t)l * 1024 * DM + (j - 2048);
            else if (j < 6144) sp = a.in[I_WGLA] + (size_t)l * 1024 * DM + (j - 4096);
            else { const int rr = j - 6144, tile = rr >> 8, w = rr & 255; sp = (w < 128 ? a.in[I_WS5V] : a.in[I_WS5G]) + (size_t)l * 1024 * DM + tile * 128 + (w & 127); }
            tr_item(sp, DM, kb * 64, (bf16_t*)(wl + WO_WBR), 1024, nb * 64, scr, lane); continue; }
        r -= C1;
        if (r < C2) { const int kb = r / 32, nb = r % 32, j = nb * 64 + nl;
            tr_item(a.in[I_WO] + (size_t)l * DM * DM + j, DM, kb * 64, (bf16_t*)(wl + WO_WO), DM, nb * 64, scr, lane); continue; }
        r -= C2;
        if (r < C3) { const int kb = r / 176, nb = r % 176, j = nb * 64 + nl; const int tile = j >> 8, w = j & 255;
            const float* sp = (w < 128 ? a.in[I_FFG] : a.in[I_FFU]) + (size_t)l * DM * DFF + tile * 128 + (w & 127);
            tr_item(sp, DFF, kb * 64, (bf16_t*)(wl + WO_WGU), DM, nb * 64, scr, lane); continue; }
        r -= C3;
        { const int kb = r / 32, nb = r % 32, j = nb * 64 + nl;
            tr_item(a.in[I_FFD] + (size_t)l * DFF * DM + j, DM, kb * 64, (bf16_t*)(wl + WO_WD), DFF, nb * 64, scr, lane); }
    }
}

__device__ __forceinline__ void p0_adaln_item(const Args& a, unsigned char* smem, int item, int tid) {
    const int lane = tid & 63, w = tid >> 6;
    float* sc = (float*)smem;
    float* red = (float*)(smem + 32768);
    const int l = item / 192, col0 = (item % 192) * 64;
    const float* wp = a.in[I_ADAW] + (size_t)l * DM * 12288 + col0 + lane;
    float acc0 = 0.f, acc1 = 0.f, acc2 = 0.f, acc3 = 0.f;
    const int k0 = w * 256;
#pragma unroll 8
    for (int k = k0; k < k0 + 256; ++k) { const float wv = wp[(size_t)k * 12288];
        acc0 += sc[k] * wv; acc1 += sc[2048 + k] * wv; acc2 += sc[4096 + k] * wv; acc3 += sc[6144 + k] * wv; }
    red[(w * 4 + 0) * 64 + lane] = acc0; red[(w * 4 + 1) * 64 + lane] = acc1; red[(w * 4 + 2) * 64 + lane] = acc2; red[(w * 4 + 3) * 64 + lane] = acc3;
    __syncthreads();
    if (tid < 256) { const int b = tid >> 6, col = tid & 63; float s = a.in[I_ADAB][l * 12288 + col0 + col];
#pragma unroll
        for (int ww = 0; ww < 8; ++ww) s += red[(ww * 4 + b) * 64 + col];
        ((float*)(a.ws + WS_MOD))[(size_t)(l * 4 + b) * 12288 + col0 + col] = s; }
    __syncthreads();
}

__device__ __forceinline__ void p0_s5pre_item(const Args& a, unsigned char* smem, int item, int tid) {
    const int l = item >> 6, g = item & 63, lg = l * 64 + g;
    float2* Bb = (float2*)(smem + 40960);
    float2* Cc = Bb + 1024;
    float2* Pw = Cc + 1024;
    float* Kt = (float*)(Pw + 17 * 64);
    float2* Ff = (float2*)(Kt + 4096);
    unsigned char* s5w = a.ws + WS_S5M + (size_t)l * S5_LAYER;
    if (tid < 64) { const int p = tid;
        const double dt = exp((double)a.in[I_LOGDT][lg]);
        const double lr = (double)a.in[I_LRE][lg * 64 + p], li = (double)a.in[I_LIM][lg * 64 + p];
        const double rev = li * dt * 0.15915494309189535;
        double abr = 0.0, abi = 0.0;
        for (int tau = 0; tau <= 16; ++tau) { const double mg = exp(lr * dt * tau); double x = rev * tau; x -= rint(x);
            const double s = sinpi(2.0 * x), c = cospi(2.0 * x);
            Pw[tau * 64 + p] = make_float2((float)(mg * c), (float)(mg * s));
            if (tau == 1) { abr = mg * c; abi = mg * s; } }
        const double den = lr * lr + li * li, nr = abr - 1.0, ni = abi;
        Ff[p] = make_float2((float)((nr * lr + ni * li) / den), (float)((ni * lr - nr * li) / den));
        ((float2*)(s5w + S5O_A16))[g * 64 + p] = Pw[16 * 64 + p];
    }
    __syncthreads();
    for (int e = tid; e < 1024; e += 512) { const int p = e >> 4;
        const float br = a.in[I_BRE][(size_t)lg * 1024 + e], bi = a.in[I_BIM][(size_t)lg * 1024 + e]; const float2 f = Ff[p];
        Bb[e] = make_float2(f.x * br - f.y * bi, f.x * bi + f.y * br);
        Cc[e] = make_float2(a.in[I_CRE][(size_t)lg * 1024 + e], a.in[I_CIM][(size_t)lg * 1024 + e]); }
    __syncthreads();
    for (int idx = tid; idx < 4096; idx += 512) { const int tau = idx >> 8, h = (idx >> 4) & 15, hp = idx & 15; float s = 0.f;
        for (int p = 0; p < 64; ++p) { const float2 c = Cc[h * 64 + p], w = Pw[tau * 64 + p], b = Bb[p * 16 + hp];
            const float cr = c.x * w.x - c.y * w.y, ci = c.x * w.y + c.y * w.x; s += cr * b.x - ci * b.y; }
        Kt[idx] = s; }
    __syncthreads();
    {
        bf16_t* MR = (bf16_t*)(s5w + S5O_MROW) + (size_t)g * 256 * 384;
        for (int e2 = tid; e2 < 256 * 192; e2 += 512) { const int n = e2 / 192, k2 = (e2 % 192) * 2; const int i = n >> 4, h = n & 15; float v[2];
#pragma unroll
            for (int u = 0; u < 2; ++u) { const int k = k2 + u;
                if (k < 256) { const int j = k >> 4, hp = k & 15; v[u] = (i >= j) ? Kt[(i - j) * 256 + h * 16 + hp] : 0.f; }
                else if (k < 320) { const int p = k - 256; const float2 c = Cc[h * 64 + p], w = Pw[(i + 1) * 64 + p]; v[u] = c.x * w.x - c.y * w.y; }
                else { const int p = k - 320; const float2 c = Cc[h * 64 + p], w = Pw[(i + 1) * 64 + p]; v[u] = -(c.x * w.y + c.y * w.x); } }
            *(unsigned*)(MR + (size_t)n * 384 + k2) = pk2(v[0], v[1]); }
        bf16_t* MI = (bf16_t*)(s5w + S5O_MIN) + (size_t)g * 128 * 256;
        for (int e2 = tid; e2 < 128 * 128; e2 += 512) { const int n2 = e2 >> 7, k2 = (e2 & 127) * 2; const int p = n2 & 63; float v[2];
#pragma unroll
            for (int u = 0; u < 2; ++u) { const int k = k2 + u, j = k >> 4, hp = k & 15; const float2 w = Pw[(15 - j) * 64 + p], b = Bb[p * 16 + hp];
                v[u] = (n2 < 64) ? (w.x * b.x - w.y * b.y) : (w.x * b.y + w.y * b.x); }
            *(unsigned*)(MI + (size_t)n2 * 256 + k2) = pk2(v[0], v[1]); }
    }
    __syncthreads();
}

__device__ __forceinline__ void ln_stats(const f32x4 (&v)[8], float& mean, float& rstd) {
    float s = 0.f;
#pragma unroll
    for (int j = 0; j < 8; ++j) s += (v[j][0] + v[j][1]) + (v[j][2] + v[j][3]);
    mean = wave_sum(s) * (1.f / DM); float q = 0.f;
#pragma unroll
    for (int j = 0; j < 8; ++j) { const f32x4 d = v[j] - mean; q += (d[0] * d[0] + d[1] * d[1]) + (d[2] * d[2] + d[3] * d[3]); }
    rstd = rsqrtf(wave_sum(q) * (1.f / DM) + 1e-5f);
}
__device__ __forceinline__ void ln_mod_store(const f32x4 (&v)[8], const float* sc, const float* sh, bf16_t* hrow, int lane) {
    float mean, rstd; ln_stats(v, mean, rstd);
#pragma unroll
    for (int j = 0; j < 8; ++j) { const int c = 4 * lane + 256 * j; const f32x4 s = *(const f32x4*)(sc + c), t = *(const f32x4*)(sh + c);
        const f32x4 y = (v[j] - mean) * rstd * (s + 1.f) + t; u32x2 w; w.x = pk2(y[0], y[1]); w.y = pk2(y[2], y[3]); *(u32x2*)(hrow + c) = w; }
}
__device__ __forceinline__ void ln_phase(const float* in, const float* g, const float* bta, float* xo, const float* modsc, const float* modsh, bf16_t* H, int gw, int ngw, int lane) {
    for (int m = gw; m < MTOK; m += ngw) {
        f32x4 v[8];
#pragma unroll
        for (int j = 0; j < 8; ++j) v[j] = *(const f32x4*)(in + (size_t)m * DM + 4 * lane + 256 * j);
        if (g) { float mean, rstd; ln_stats(v, mean, rstd);
#pragma unroll
            for (int j = 0; j < 8; ++j) { const int c = 4 * lane + 256 * j; const f32x4 gg = *(const f32x4*)(g + c), bb = *(const f32x4*)(bta + c);
                v[j] = (v[j] - mean) * rstd * gg + bb; *(f32x4*)(xo + (size_t)m * DM + c) = v[j]; } }
        if (modsc) { const int b = m >> 11; ln_mod_store(v, modsc + (size_t)b * 12288, modsh + (size_t)b * 12288, H + (size_t)m * DM, lane); }
    }
}

__device__ __forceinline__ void conv_item(const bf16_t* P, bf16_t* BR, const float* cw, int it, int tid) {
    const int idx = it * 512 + tid, m = idx >> 7, c8 = (idx & 127) * 8, t = m & (SEQ - 1);
    const bf16_t* pr = P + (size_t)m * NPROJ;
    float accv[8];
#pragma unroll
    for (int i = 0; i < 8; ++i) accv[i] = 0.f;
#pragma unroll
    for (int j = 0; j < 3; ++j) { const int dtk = 2 - j; if (t - dtk < 0) continue;
        const bf16_t* pj = pr - (size_t)dtk * NPROJ;
        const u32x4 cc = *(const u32x4*)(pj + C_CVC + c8), xx = *(const u32x4*)(pj + C_CVX + c8);
        const f32x4 w0 = *(const f32x4*)(cw + j * 1024 + c8), w1 = *(const f32x4*)(cw + j * 1024 + c8 + 4);
        accv[0] += w0[0] * lo16(cc.x) * lo16(xx.x); accv[1] += w0[1] * hi16(cc.x) * hi16(xx.x);
        accv[2] += w0[2] * lo16(cc.y) * lo16(xx.y); accv[3] += w0[3] * hi16(cc.y) * hi16(xx.y);
        accv[4] += w1[0] * lo16(cc.z) * lo16(xx.z); accv[5] += w1[1] * hi16(cc.z) * hi16(xx.z);
        accv[6] += w1[2] * lo16(cc.w) * lo16(xx.w); accv[7] += w1[3] * hi16(cc.w) * hi16(xx.w); }
    const u32x4 bb = *(const u32x4*)(pr + C_CVB + c8);
    u32x4 o; o.x = pk2(accv[0] * lo16(bb.x), accv[1] * hi16(bb.x)); o.y = pk2(accv[2] * lo16(bb.y), accv[3] * hi16(bb.y));
    o.z = pk2(accv[4] * lo16(bb.z), accv[5] * hi16(bb.z)); o.w = pk2(accv[6] * lo16(bb.w), accv[7] * hi16(bb.w));
    *(u32x4*)(BR + (size_t)m * NBR + BR_CONV + c8) = o;
}

__device__ __forceinline__ void s5a_item(const bf16_t* P, const bf16_t* MIN, float* SLOC, int wi, int lane) {
    const int g = wi >> 5, ct = wi & 31, c16 = lane & 15, q = lane >> 4;
    const int cc = ct * 16 + c16, b = cc >> 7, c = cc & 127;
    bf16x8 bf[8];
#pragma unroll
    for (int ks = 0; ks < 8; ++ks) bf[ks] = *(const bf16x8*)(P + (size_t)(b * SEQ + c * 16 + 2 * ks + (q >> 1)) * NPROJ + C_S5U + g * 16 + (q & 1) * 8);
    const bf16_t* Mg = MIN + (size_t)g * 128 * 256;
    float* out = SLOC + ((size_t)(b * 128 + c) * 64 + g) * 128;
#pragma unroll
    for (int rt = 0; rt < 8; ++rt) { f32x4 acc = {0.f, 0.f, 0.f, 0.f};
#pragma unroll
        for (int ks = 0; ks < 8; ++ks) { const bf16x8 af = *(const bf16x8*)(Mg + (size_t)(16 * rt + c16) * 256 + 32 * ks + 8 * q); acc = MFMA16(af, bf[ks], acc); }
        *(f32x4*)(out + 16 * rt + 4 * q) = acc; }
}

__device__ __forceinline__ void s5c_item(const bf16_t* P, const bf16_t* MROW, const bf16_t* SPREV, const float* dsk, bf16_t* BR, int wi, int lane) {
    const int g = wi >> 5, ct = wi & 31, c16 = lane & 15, q = lane >> 4;
    const int cc = ct * 16 + c16, b = cc >> 7, c = cc & 127;
    bf16x8 bf[12];
#pragma unroll
    for (int ks = 0; ks < 8; ++ks) bf[ks] = *(const bf16x8*)(P + (size_t)(b * SEQ + c * 16 + 2 * ks + (q >> 1)) * NPROJ + C_S5U + g * 16 + (q & 1) * 8);
    const bf16_t* sp = SPREV + ((size_t)(b * 128 + c) * 64 + g) * 128;
#pragma unroll
    for (int ks = 0; ks < 4; ++ks) bf[8 + ks] = *(const bf16x8*)(sp + 32 * ks + 8 * q);
    const bf16_t* Mg = MROW + (size_t)g * 256 * 384;
    const f32x4 dv = *(const f32x4*)(dsk + g * 16 + 4 * q);
#pragma unroll
    for (int i = 0; i < 16; ++i) { f32x4 acc = {0.f, 0.f, 0.f, 0.f};
        const bf16_t* mrow = Mg + (size_t)(16 * i + c16) * 384 + 8 * q;
#pragma unroll
        for (int ks = 0; ks < 8; ++ks) if (ks <= (i >> 1)) { const bf16x8 af = *(const bf16x8*)(mrow + 32 * ks); acc = MFMA16(af, bf[ks], acc); }
#pragma unroll
        for (int ks = 8; ks < 12; ++ks) { const bf16x8 af = *(const bf16x8*)(mrow + 32 * ks); acc = MFMA16(af, bf[ks], acc); }
        const size_t m = (size_t)b * SEQ + c * 16 + i;
        const u32x2 uw = *(const u32x2*)(P + m * NPROJ + C_S5U + g * 16 + 4 * q);
        const float y0 = acc[0] + dv[0] * lo16(uw.x), y1 = acc[1] + dv[1] * hi16(uw.x), y2 = acc[2] + dv[2] * lo16(uw.y), y3 = acc[3] + dv[3] * hi16(uw.y);
        u32x2 o; o.x = pk2(gelu_tanh(y0), gelu_tanh(y1)); o.y = pk2(gelu_tanh(y2), gelu_tanh(y3));
        *(u32x2*)(BR + m * NBR + BR_S5 + g * 16 + 4 * q) = o; }
}

__device__ __forceinline__ void stage_vt64(const bf16_t* P, size_t m0, int vcol0, bf16_t* VT, int tid) {
#pragma unroll
    for (int i = 0; i < 4; ++i) { const int id = tid + 512 * i, t = id >> 5, v8 = (id & 31) * 8;
        const u32x4 vv = *(const u32x4*)(P + (m0 + t) * NPROJ + vcol0 + v8);
        VT[(v8 + 0) * 72 + t] = (bf16_t)(vv.x & 0xffffu); VT[(v8 + 1) * 72 + t] = (bf16_t)(vv.x >> 16);
        VT[(v8 + 2) * 72 + t] = (bf16_t)(vv.y & 0xffffu); VT[(v8 + 3) * 72 + t] = (bf16_t)(vv.y >> 16);
        VT[(v8 + 4) * 72 + t] = (bf16_t)(vv.z & 0xffffu); VT[(v8 + 5) * 72 + t] = (bf16_t)(vv.z >> 16);
        VT[(v8 + 6) * 72 + t] = (bf16_t)(vv.w & 0xffffu); VT[(v8 + 7) * 72 + t] = (bf16_t)(vv.w >> 16); }
}

__device__ __forceinline__ void glaa_item(const bf16_t* P, const float* wgate, const float* bgate, float* BCUM, float* AEND, float* LCT, unsigned char* smem, int it, int tid) {
    const int bh = it >> 5, cn = it & 31, b = bh >> 2, h = bh & 3; const size_t m0 = (size_t)b * SEQ + cn * 64;
    const int lane = tid & 63, w = tid >> 6, c16 = lane & 15, q = lane >> 4;
    float* lrs = (float*)smem;
    float* part = (float*)(smem + 4096);
    bf16_t* KdT = (bf16_t*)(smem + 8192);
    bf16_t* VT = (bf16_t*)(smem + 8192 + 18432);
    if (tid < 128) { const int t = tid >> 1, hf = tid & 1; const u32x4 v = *(const u32x4*)(P + (m0 + t) * NPROJ + C_GLLR + hf * 8);
        float* d = lrs + t * 16 + hf * 8; d[0] = lo16(v.x); d[1] = hi16(v.x); d[2] = lo16(v.y); d[3] = hi16(v.y); d[4] = lo16(v.z); d[5] = hi16(v.z); d[6] = lo16(v.w); d[7] = hi16(v.w); }
    stage_vt64(P, m0, C_GLV + h * 256, VT, tid);
    __syncthreads();
    const int k = tid & 127, tg = tid >> 7;
    float wg[16];
#pragma unroll
    for (int r = 0; r < 16; ++r) wg[r] = wgate[r * 512 + h * 128 + k];
    const float bias = bgate[h * 128 + k];
    float bl[16]; float run = 0.f;
#pragma unroll
    for (int tt = 0; tt < 16; ++tt) { const float* lr = lrs + (16 * tg + tt) * 16; float z = bias;
#pragma unroll
        for (int r = 0; r < 16; ++r) z += lr[r] * wg[r];
        const float la = (fminf(z, 0.f) - __logf(1.f + __expf(-fabsf(z)))) * (1.f / 16.f);
        run += la; bl[tt] = run; }
    part[tg * 128 + k] = run;
    __syncthreads();
    float off = 0.f, bend = 0.f;
#pragma unroll
    for (int g2 = 0; g2 < 4; ++g2) { const float pv = part[g2 * 128 + k]; bend += pv; if (g2 < tg) off += pv; }
    if (tg == 0) AEND[(size_t)(bh * 32 + cn) * 128 + k] = __expf(bend);
    unsigned kd[8];
#pragma unroll
    for (int tt = 0; tt < 16; tt += 2) {
        const float b0 = bl[tt] + off, b1 = bl[tt + 1] + off; const size_t t0 = m0 + 16 * tg + tt;
        BCUM[t0 * 512 + h * 128 + k] = b0; BCUM[(t0 + 1) * 512 + h * 128 + k] = b1;
        const float k0v = bf2f(P[t0 * NPROJ + C_GLK + h * 128 + k]), k1v = bf2f(P[(t0 + 1) * NPROJ + C_GLK + h * 128 + k]);
        kd[tt >> 1] = pk2(k0v * __expf(bend - b0), k1v * __expf(bend - b1)); }
    { u32x4 w0, w1; w0.x = kd[0]; w0.y = kd[1]; w0.z = kd[2]; w0.w = kd[3]; w1.x = kd[4]; w1.y = kd[5]; w1.z = kd[6]; w1.w = kd[7];
      *(u32x4*)(KdT + k * 72 + 16 * tg) = w0; *(u32x4*)(KdT + k * 72 + 16 * tg + 8) = w1; }
    __syncthreads();
    float* out = LCT + (size_t)(bh * 32 + cn) * 32768;
#pragma unroll
    for (int vi = 0; vi < 2; ++vi) { const int vt = 2 * w + vi;
        const bf16x8 a0 = *(const bf16x8*)(VT + (16 * vt + c16) * 72 + 8 * q), a1 = *(const bf16x8*)(VT + (16 * vt + c16) * 72 + 32 + 8 * q);
#pragma unroll
        for (int kt = 0; kt < 8; ++kt) { f32x4 acc = {0.f, 0.f, 0.f, 0.f};
            const bf16x8 b0 = *(const bf16x8*)(KdT + (16 * kt + c16) * 72 + 8 * q), b1 = *(const bf16x8*)(KdT + (16 * kt + c16) * 72 + 32 + 8 * q);
            acc = MFMA16(a0, b0, acc); acc = MFMA16(a1, b1, acc);
#pragma unroll
            for (int j = 0; j < 4; ++j) out[(size_t)(16 * vt + 4 * q + j) * 128 + 16 * kt + c16] = acc[j]; } }
    __syncthreads();
}

__device__ __forceinline__ void glac_item(const bf16_t* P, const float* BCUM, const bf16_t* SNT, const float* gn, bf16_t* BR, unsigned char* smem, int it, int tid) {
    const int bh = it >> 5, cn = it & 31, b = bh >> 2, h = bh & 3; const size_t m0 = (size_t)b * SEQ + cn * 64;
    const int lane = tid & 63, w = tid >> 6, c16 = lane & 15, q = lane >> 4;
    bf16_t* Qd = (bf16_t*)smem;
    bf16_t* Ki = (bf16_t*)(smem + 17408);
    bf16_t* Pm = (bf16_t*)(smem + 34816);
    bf16_t* VT = (bf16_t*)(smem + 44032);
    float* st = (float*)(smem + 44032 + 36864);
    stage_vt64(P, m0, C_GLV + h * 256, VT, tid);
    { const int k = tid & 127, tg = tid >> 7;
#pragma unroll 4
      for (int tt = 0; tt < 16; ++tt) { const int t = 16 * tg + tt; const size_t m = m0 + t;
          const float bv = BCUM[m * 512 + h * 128 + k];
          const float qv = bf2f(P[m * NPROJ + C_GLQ + h * 128 + k]), kv = bf2f(P[m * NPROJ + C_GLK + h * 128 + k]);
          Qd[t * 136 + k] = (bf16_t)f2bf(qv * QSCALE * __expf(bv)); Ki[t * 136 + k] = (bf16_t)f2bf(kv * __expf(-bv)); } }
    __syncthreads();
#pragma unroll
    for (int ti = 0; ti < 2; ++ti) { const int tile = 2 * w + ti, tt = tile >> 2, stl = tile & 3; f32x4 acc = {0.f, 0.f, 0.f, 0.f};
        if (stl <= tt) {
#pragma unroll
            for (int ks = 0; ks < 4; ++ks) { const bf16x8 af = *(const bf16x8*)(Qd + (16 * tt + c16) * 136 + 32 * ks + 8 * q), bfr = *(const bf16x8*)(Ki + (16 * stl + c16) * 136 + 32 * ks + 8 * q);
                acc = MFMA16(af, bfr, acc); } }
#pragma unroll
        for (int j = 0; j < 4; ++j) { const int t = 16 * tt + 4 * q + j, s = 16 * stl + c16; Pm[t * 72 + s] = (bf16_t)f2bf((s <= t) ? acc[j] : 0.f); } }
    __syncthreads();
    {
        const int tt = w & 3, vt0 = 8 * (w >> 2);
        bf16x8 pa[2], qa[4];
#pragma unroll
        for (int ks = 0; ks < 2; ++ks) pa[ks] = *(const bf16x8*)(Pm + (16 * tt + c16) * 72 + 32 * ks + 8 * q);
#pragma unroll
        for (int ks = 0; ks < 4; ++ks) qa[ks] = *(const bf16x8*)(Qd + (16 * tt + c16) * 136 + 32 * ks + 8 * q);
        const bf16_t* Sg = SNT + (size_t)(bh * 32 + cn) * 32768;
        f32x4 o[8];
#pragma unroll
        for (int vi = 0; vi < 8; ++vi) { const int vt = vt0 + vi; f32x4 acc = {0.f, 0.f, 0.f, 0.f};
#pragma unroll
            for (int ks = 0; ks < 2; ++ks) { const bf16x8 bfr = *(const bf16x8*)(VT + (16 * vt + c16) * 72 + 32 * ks + 8 * q); acc = MFMA16(pa[ks], bfr, acc); }
#pragma unroll
            for (int ks = 0; ks < 4; ++ks) { const bf16x8 bfr = *(const bf16x8*)(Sg + (size_t)(16 * vt + c16) * 128 + 32 * ks + 8 * q); acc = MFMA16(qa[ks], bfr, acc); }
            o[vi] = acc; }
        float s1[4], s2[4];
#pragma unroll
        for (int j = 0; j < 4; ++j) { float a1 = 0.f, a2 = 0.f;
#pragma unroll
            for (int vi = 0; vi < 8; ++vi) { a1 += o[vi][j]; a2 += o[vi][j] * o[vi][j]; }
#pragma unroll
            for (int x = 1; x < 16; x <<= 1) { a1 += __shfl_xor(a1, x); a2 += __shfl_xor(a2, x); }
            s1[j] = a1; s2[j] = a2; }
        if (c16 == 0) {
#pragma unroll
            for (int j = 0; j < 4; ++j) { st[((w >> 2) * 64 + 16 * tt + 4 * q + j) * 2] = s1[j]; st[((w >> 2) * 64 + 16 * tt + 4 * q + j) * 2 + 1] = s2[j]; } }
        __syncthreads();
#pragma unroll
        for (int j = 0; j < 4; ++j) { const int t = 16 * tt + 4 * q + j;
            const float a1 = st[t * 2] + st[(64 + t) * 2], a2 = st[t * 2 + 1] + st[(64 + t) * 2 + 1];
            const float mean = a1 * (1.f / 256.f), var = a2 * (1.f / 256.f) - mean * mean, rstd = rsqrtf(var + 1e-5f);
            const size_t m = m0 + t;
#pragma unroll
            for (int vi = 0; vi < 8; ++vi) { const int v = 16 * (vt0 + vi) + c16;
                const float r = bf2f(P[m * NPROJ + C_GLR + h * 256 + v]);
                BR[m * NBR + BR_GLA + h * 256 + v] = (bf16_t)f2bf((o[vi][j] - mean) * rstd * gn[h * 256 + v] * siluf_(r)); } }
    }
    __syncthreads();
}

template <bool MASKED>
__device__ __forceinline__ void sb_weights(const f32x4 (&s)[4], int key0, int tq, int q, float& R, bf16x8& wA, bf16x8& wB) {
    constexpr float SC2 = QSCALE * 1.4426950408889634f;
    float z[4][4], c[4][4];
#pragma unroll
    for (int sb = 0; sb < 4; ++sb)
#pragma unroll
        for (int j = 0; j < 4; ++j) { z[sb][j] = s[sb][j] * SC2; const float sp = __builtin_amdgcn_logf(1.f + __builtin_amdgcn_exp2f(z[sb][j]));
            c[sb][j] = (!MASKED || (key0 + 16 * sb + 4 * q + j) < tq) ? sp : 0.f; }
    float aft[4], all[4];
#pragma unroll
    for (int sb = 0; sb < 4; ++sb) { c[sb][2] += c[sb][3]; c[sb][1] += c[sb][2]; c[sb][0] += c[sb][1];
        const float T = c[sb][0], ax = __shfl_xor(T, 16), bx = T + ax, cx = __shfl_xor(bx, 32);
        aft[sb] = ((q & 1) ? 0.f : ax) + ((q & 2) ? 0.f : cx); all[sb] = bx + cx; }
    float base[4];
    base[3] = R + aft[3]; base[2] = R + all[3] + aft[2]; base[1] = R + all[3] + all[2] + aft[1]; base[0] = R + all[3] + all[2] + all[1] + aft[0];
    R += (all[0] + all[1]) + (all[2] + all[3]);
    float wv[4][4];
#pragma unroll
    for (int sb = 0; sb < 4; ++sb)
#pragma unroll
        for (int j = 0; j < 4; ++j) { const float e = __builtin_amdgcn_exp2f(z[sb][j] - (c[sb][j] + base[sb]));
            wv[sb][j] = (!MASKED || (key0 + 16 * sb + 4 * q + j) < tq) ? e : 0.f; }
    union { bf16x8 v; unsigned u[4]; } a, b;
    a.u[0] = pk2(wv[0][0], wv[0][1]); a.u[1] = pk2(wv[0][2], wv[0][3]); a.u[2] = pk2(wv[1][0], wv[1][1]); a.u[3] = pk2(wv[1][2], wv[1][3]);
    b.u[0] = pk2(wv[2][0], wv[2][1]); b.u[1] = pk2(wv[2][2], wv[2][3]); b.u[2] = pk2(wv[3][0], wv[3][1]); b.u[3] = pk2(wv[3][2], wv[3][3]);
    wA = a.v; wB = b.v;
}

__device__ __forceinline__ void attn_unit(const bf16_t* P, bf16_t* BR, unsigned char* smem, int unit, int tid) {
    const int lane = tid & 63, w = tid >> 6, c16 = lane & 15, q = lane >> 4;
    bf16_t* KsB = (bf16_t*)smem;
    bf16_t* VTB = (bf16_t*)(smem + 34816);
    const int bh = unit >> 3, pr = unit & 7, b = bh >> 3, h = bh & 7;
    const int lkey = tid >> 4, ld8 = (tid & 15) * 8;
    const int keyA = lkey ^ (4 * (tid & 15)), keyB = keyA ^ 32;
    const bf16_t* Kg = P + (size_t)b * SEQ * NPROJ + C_SBK + h * 128 + ld8;
    const bf16_t* Vg = P + (size_t)b * SEQ * NPROJ + C_SBV + h * 128 + ld8;
    for (int half = 0; half < 2; ++half) {
        const int qb = half ? 15 - pr : pr;
        const int tq = qb * 128 + 16 * w + c16;
        const size_t mq = (size_t)b * SEQ + tq;
        bf16x8 qf[4];
#pragma unroll
        for (int ks = 0; ks < 4; ++ks) qf[ks] = *(const bf16x8*)(P + mq * NPROJ + C_SBQ + h * 128 + 32 * ks + 8 * q);
        f32x4 o[8];
#pragma unroll
        for (int d = 0; d < 8; ++d) o[d] = (f32x4){0.f, 0.f, 0.f, 0.f};
        float R = 0.f;
        const int nt = 2 * qb + 2;
        u32x4 pk0, pk1, pv0, pv1;
        { const size_t r0 = (size_t)((nt - 1) * 64 + lkey) * NPROJ, r1 = r0 + (size_t)32 * NPROJ;
          pk0 = *(const u32x4*)(Kg + r0); pk1 = *(const u32x4*)(Kg + r1); pv0 = *(const u32x4*)(Vg + r0); pv1 = *(const u32x4*)(Vg + r1); }
        for (int it = 0; it < nt; ++it) {
            const int kt = nt - 1 - it, key0 = kt * 64;
            bf16_t* Ks = KsB + (it & 1) * 8704; bf16_t* VT = VTB + (it & 1) * 9216;
            *(u32x4*)(Ks + lkey * 136 + ld8) = pk0; *(u32x4*)(Ks + (32 + lkey) * 136 + ld8) = pk1;
            { bf16_t* vd = VT + ld8 * 72 + keyA;
              vd[0 * 72] = (bf16_t)(pv0.x & 0xffffu); vd[1 * 72] = (bf16_t)(pv0.x >> 16); vd[2 * 72] = (bf16_t)(pv0.y & 0xffffu); vd[3 * 72] = (bf16_t)(pv0.y >> 16);
              vd[4 * 72] = (bf16_t)(pv0.z & 0xffffu); vd[5 * 72] = (bf16_t)(pv0.z >> 16); vd[6 * 72] = (bf16_t)(pv0.w & 0xffffu); vd[7 * 72] = (bf16_t)(pv0.w >> 16);
              vd = VT + ld8 * 72 + keyB;
              vd[0 * 72] = (bf16_t)(pv1.x & 0xffffu); vd[1 * 72] = (bf16_t)(pv1.x >> 16); vd[2 * 72] = (bf16_t)(pv1.y & 0xffffu); vd[3 * 72] = (bf16_t)(pv1.y >> 16);
              vd[4 * 72] = (bf16_t)(pv1.z & 0xffffu); vd[5 * 72] = (bf16_t)(pv1.z >> 16); vd[6 * 72] = (bf16_t)(pv1.w & 0xffffu); vd[7 * 72] = (bf16_t)(pv1.w >> 16); }
            __syncthreads();
            if (it + 1 < nt) { const size_t r0 = (size_t)((kt - 1) * 64 + lkey) * NPROJ, r1 = r0 + (size_t)32 * NPROJ;
                pk0 = *(const u32x4*)(Kg + r0); pk1 = *(const u32x4*)(Kg + r1); pv0 = *(const u32x4*)(Vg + r0); pv1 = *(const u32x4*)(Vg + r1); }
            const int tmin = qb * 128 + 16 * w;
            if (key0 <= tmin + 15) {
                f32x4 s[4];
#pragma unroll
                for (int sb = 0; sb < 4; ++sb) s[sb] = (f32x4){0.f, 0.f, 0.f, 0.f};
#pragma unroll
                for (int ks = 0; ks < 4; ++ks)
#pragma unroll
                    for (int sb = 0; sb < 4; ++sb) { const bf16x8 af = *(const bf16x8*)(Ks + (16 * sb + c16) * 136 + 32 * ks + 8 * q); s[sb] = MFMA16(af, qf[ks], s[sb]); }
                bf16x8 wA, wB;
                if (key0 + 64 <= tmin) sb_weights<false>(s, key0, tq, q, R, wA, wB);
                else sb_weights<true>(s, key0, tq, q, R, wA, wB);
#pragma unroll
                for (int dt = 0; dt < 8; ++dt) { const int m = (2 * dt + (c16 >> 3)) & 15; const bf16_t* vr = VT + (16 * dt + c16) * 72;
                    union { bf16x8 v; s16x4 hlf[2]; } aA, aB;
                    aA.hlf[0] = *(const s16x4*)(vr + 4 * (q ^ m)); aA.hlf[1] = *(const s16x4*)(vr + 4 * ((q + 4) ^ m));
                    aB.hlf[0] = *(const s16x4*)(vr + 4 * ((q + 8) ^ m)); aB.hlf[1] = *(const s16x4*)(vr + 4 * ((q + 12) ^ m));
                    o[dt] = MFMA16(aA.v, wA, o[dt]); o[dt] = MFMA16(aB.v, wB, o[dt]); }
            }
        }
#pragma unroll
        for (int dt = 0; dt < 8; ++dt) { u32x2 ov; ov.x = pk2(o[dt][0], o[dt][1]); ov.y = pk2(o[dt][2], o[dt][3]);
            *(u32x2*)(BR + mq * NBR + BR_SB + h * 128 + 16 * dt + 4 * q) = ov; }
    }
    __syncthreads();
}

#define XB_TMO      128
#define XB_XCNT(j)  (256  + 64 * (j))
#define XB_XSUB(j)  (1280 + 64 * (j))
#define XB_XGEN(j)  (2304 + 64 * (j))
#define XB_TOP      3328
#define XB_TOPGEN   3392
#define XCD_BAR_WORDS 3456
#define XB_SPIN_CAP (1u << 22)
__device__ __forceinline__ unsigned xb_ld(unsigned* p)              { return __hip_atomic_load(p, __ATOMIC_RELAXED, __HIP_MEMORY_SCOPE_AGENT); }
__device__ __forceinline__ unsigned xb_add(unsigned* p, unsigned v) { return __hip_atomic_fetch_add(p, v, __ATOMIC_RELAXED, __HIP_MEMORY_SCOPE_AGENT); }
__device__ __forceinline__ unsigned xb_xcc_id() { return (unsigned)__builtin_amdgcn_s_getreg((3 << 11) | 20) & 0xFu; }
#define XB_SPIN(cond, bar) do { unsigned _sp = 0; while (cond) { __builtin_amdgcn_s_sleep(1); \
    if ((++_sp & 255u) == 0u) { if (xb_ld(&(bar)[XB_TMO])) break; if (_sp > XB_SPIN_CAP) { atomicAdd(&(bar)[XB_TMO], 1u); break; } } } } while (0)
struct XcdBarrier { unsigned* bar; unsigned x; volatile LAS unsigned* st; };
__device__ __forceinline__ XcdBarrier xcd_barrier_post(unsigned* bar, volatile LAS unsigned* st) {
    XcdBarrier b; b.bar = bar; b.x = xb_xcc_id(); b.st = st;
    if (threadIdx.x == 0) (void)xb_add(&bar[XB_XCNT(b.x)], 1u);
    return b;
}
__device__ __forceinline__ void xcd_barrier_complete(unsigned* bar, unsigned x, unsigned& nloc, unsigned& nx) {
    const unsigned G = gridDim.x * gridDim.y * gridDim.z;
    unsigned sum, cnt, mine, sp = 0u;
    for (;;) {
        sum = 0u; cnt = 0u; mine = 0u;
#pragma unroll
        for (unsigned j = 0; j < 16; ++j) { const unsigned c = xb_ld(&bar[XB_XCNT(j)]); sum += c; cnt += (c > 0u) ? 1u : 0u; mine = (j == x) ? c : mine; }
        if (sum == G) break;
        __builtin_amdgcn_s_sleep(1);
        if ((++sp & 255u) == 0u) { if (xb_ld(&bar[XB_TMO])) break; if (sp > XB_SPIN_CAP) { atomicAdd(&bar[XB_TMO], 1u); break; } }
    }
    nloc = mine > 0u ? mine : 1u; nx = cnt > 0u ? cnt : 1u;
}
__device__ __forceinline__ void xcd_barrier(const XcdBarrier& b) {
    asm volatile("s_waitcnt vmcnt(0)" ::: "memory");
    __syncthreads();
    if (threadIdx.x == 0) {
        unsigned* bar = b.bar;
        __builtin_amdgcn_s_waitcnt(0);
        unsigned nloc = b.st[0], nx = b.st[1];
        if (nloc == 0u) { xcd_barrier_complete(bar, b.x, nloc, nx); b.st[0] = nloc; b.st[1] = nx; }
        const unsigned old = xb_add(&bar[XB_XSUB(b.x)], 1u);
        const unsigned gen = old / nloc;
        if (old + 1u == (gen + 1u) * nloc) {
            __builtin_amdgcn_fence(__ATOMIC_RELEASE, "agent");
            asm volatile("s_waitcnt vmcnt(0)" ::: "memory");
            const unsigned og = xb_add(&bar[XB_TOP], 1u);
            const unsigned tg = og / nx;
            if (og + 1u == (tg + 1u) * nx) xb_add(&bar[XB_TOPGEN], 1u);
            else XB_SPIN(xb_ld(&bar[XB_TOPGEN]) == tg, bar);
            __builtin_amdgcn_fence(__ATOMIC_ACQUIRE, "agent");
            xb_add(&bar[XB_XGEN(b.x)], 1u);
            asm volatile("s_waitcnt vmcnt(0)" ::: "memory");
        } else {
            XB_SPIN(xb_ld(&bar[XB_XGEN(b.x)]) == gen, bar);
            __builtin_amdgcn_fence(__ATOMIC_ACQUIRE, "agent");
            asm volatile("s_waitcnt vmcnt(0)" ::: "memory");
        }
    }
    __syncthreads();
}

constexpr int NPH = 23;
__global__ void __launch_bounds__(512, 2) mk_fwd(Args a) {
    extern __shared__ __attribute__((aligned(16))) unsigned char smem[];
    cg::grid_group grid = cg::this_grid();
    int tid = threadIdx.x, lane = tid & 63, wave = __builtin_amdgcn_readfirstlane(tid >> 6);
    int G = gridDim.x, bid = blockIdx.x, gw = bid * 8 + wave, ngw = G * 8;
    LAS unsigned char* lds = (LAS unsigned char*)smem;
    unsigned char* ws = a.ws;
    float* MOD = (float*)(ws + WS_MOD);
    bf16_t* H = (bf16_t*)(ws + WS_H); bf16_t* PROJ = (bf16_t*)(ws + WS_PROJ); bf16_t* ACT = (bf16_t*)(ws + WS_ACT);
    bf16_t* BR = (bf16_t*)(ws + WS_BR); float* Y = (float*)(ws + WS_Y); bf16_t* MBF = (bf16_t*)(ws + WS_MB); float* X1 = (float*)(ws + WS_X1);
    float* SLOC = (float*)(ws + WS_SLOC); bf16_t* SPREV = (bf16_t*)(ws + WS_SPREV); float* BCUM = (float*)(ws + WS_BCUM);
    float* AEND = (float*)(ws + WS_AEND); float* LCT = (float*)(ws + WS_LCT); bf16_t* SNT = (bf16_t*)(ws + WS_SNT);
    const int lo = a.ph_lo, hi = a.ph_hi;
    volatile LAS unsigned* xst = (volatile LAS unsigned*)(lds + LDS_BYTES - 64);
    if (tid == 0) { xst[0] = 0u; xst[1] = 0u; }
    __syncthreads();
    XcdBarrier xbar = xcd_barrier_post((unsigned*)(ws + WS_CTL), xst);
#define IN(k) (lo <= (k) && (k) < hi)
#ifndef REPMASK
#define REPMASK 0u
#endif
#define REPS(kind) ((((unsigned)(REPMASK) >> (kind)) & 1u) ? 2 : 1)
#define PHASE(k, kind) if (IN(k)) for (int rep_ = 0; rep_ < REPS(kind); ++rep_, (rep_ < REPS(kind) ? (xcd_barrier(xbar), 0) : 0))
#define SEAM(k) do { if (IN(k) && IN((k) + 1)) { if ((k) == 0) grid.sync(); else xcd_barrier(xbar); } FRESH(); } while (0)
#define FRESH() do { tid = threadIdx.x; asm volatile("" : "+v"(tid)); lane = tid & 63; wave = __builtin_amdgcn_readfirstlane(tid >> 6); bid = blockIdx.x; asm volatile("" : "+s"(bid)); G = gridDim.x; asm volatile("" : "+s"(G)); gw = bid * 8 + wave; ngw = G * 8; } while (0)

    PHASE(0, 0) {
        {
            float* sc = (float*)smem;
            for (int i = tid; i < NB * DM; i += 512) sc[i] = siluf_(a.in[I_C][i]);
            __syncthreads();
            for (int it = bid; it < 384; it += G) p0_adaln_item(a, smem, it, tid);
            __syncthreads();
        }
        for (int it = bid; it < 128; it += G) p0_s5pre_item(a, smem, it, tid);
        __syncthreads();
        p0_transposes(a, smem, gw, ngw, wave, lane);
        __syncthreads();
    }
    SEAM(0);

    for (int l = 0; l < 2; ++l) {
        const int pb = 1 + 11 * l;
        const unsigned char* wl = ws + WS_W + (size_t)l * W_LAYER;
        const unsigned char* s5w = ws + WS_S5M + (size_t)l * S5_LAYER;
        const float* modl = MOD + (size_t)l * 4 * 12288;
        const float* xin = l == 0 ? a.in[I_X] : a.out;
        PHASE(pb + 0, 1) if (l == 0) ln_phase(xin, nullptr, nullptr, nullptr, modl + 2048, modl, H, gw, ngw, lane);
        if (l == 0) SEAM(pb + 0);
        PHASE(pb + 1, 2) { pg8::Gemm g{H, (const bf16_t*)(wl + WO_WIN), DM, DM, DM}; pg8::StaticOrder S; S.init(MTOK, NPROJ, G, bid);
            pg8::EpiBf16 E{PROJ, NPROJ}; pg8::gemm_phase(lds, g, S, E, tid); }
        SEAM(pb + 1);
        PHASE(pb + 2, 3) {
#ifndef REP_ATTN
#define REP_ATTN 1
#endif
#ifndef REP_GLAA
#define REP_GLAA 1
#endif
            for (int rr = 0; rr < REP_ATTN; ++rr) for (int u = bid; u < 256; u += G) attn_unit(PROJ, BR, smem, u, tid);
            for (int rr = 0; rr < REP_GLAA; ++rr) for (int it = bid; it < 512; it += G) glaa_item(PROJ, a.in[I_GLAWG] + (size_t)l * 16 * 512, a.in[I_GLABG] + l * 512, BCUM, AEND, LCT, smem, it, tid);
            for (int it = gw; it < 2048; it += ngw) s5a_item(PROJ, (const bf16_t*)(s5w + S5O_MIN), SLOC, it, lane);
            for (int it = bid; it < 2048; it += G) conv_item(PROJ, BR, a.in[I_CONVW] + (size_t)l * 3 * 1024, it, tid);
        }
        SEAM(pb + 2);
        PHASE(pb + 3, 4) {
            for (int it = bid; it < 32 + 1024; it += G) {
                if (it < 32) { const int idx = it * 512 + tid, b = idx >> 12, g = (idx >> 6) & 63, p = idx & 63;
                    const float2 ab = ((const float2*)(s5w + S5O_A16))[g * 64 + p]; float sr = 0.f, si = 0.f;
#pragma unroll 4
                    for (int c = 0; c < 128; ++c) { const size_t base = ((size_t)(b * 128 + c) * 64 + g) * 128;
                        SPREV[base + p] = (bf16_t)f2bf(sr); SPREV[base + 64 + p] = (bf16_t)f2bf(si);
                        const float lr = SLOC[base + p], li = SLOC[base + 64 + p];
                        const float nr = ab.x * sr - ab.y * si + lr, ni = ab.x * si + ab.y * sr + li; sr = nr; si = ni; } }
                else { const int idx = (it - 32) * 512 + tid, bh = idx >> 15, e = idx & 32767, k = e & 127; float s = 0.f;
#pragma unroll 4
                    for (int cn = 0; cn < 32; ++cn) { const size_t base = (size_t)(bh * 32 + cn);
                        SNT[base * 32768 + e] = (bf16_t)f2bf(s);
                        s = AEND[base * 128 + k] * s + LCT[base * 32768 + e]; } }
            }
        }
        SEAM(pb + 3);
        PHASE(pb + 4, 5) {
            for (int it = bid; it < 512; it += G) glac_item(PROJ, BCUM, SNT, a.in[I_GLANG] + l * 1024, BR, smem, it, tid);
            for (int it = gw; it < 2048; it += ngw) s5c_item(PROJ, (const bf16_t*)(s5w + S5O_MROW), SPREV, a.in[I_S5D] + l * 1024, BR, it, lane);
        }
        SEAM(pb + 4);
        PHASE(pb + 5, 6) { pg8::Gemm g{BR, (const bf16_t*)(wl + WO_WBR), NBR, 1024, 1024}; pg8::BranchOrder S{G, bid};
            pg8::EpiBranch E{PROJ, Y, MBF}; pg8::gemm_phase(lds, g, S, E, tid); }
        SEAM(pb + 5);
        PHASE(pb + 6, 7) { pg8::Gemm g{MBF, (const bf16_t*)(wl + WO_WO), DM, DM, DM}; pg8::StaticOrder S; S.init(MTOK, DM, G, bid);
            pg8::EpiResid E{xin, modl + 2 * 2048, Y}; pg8::gemm_phase(lds, g, S, E, tid); }
        SEAM(pb + 6);
        PHASE(pb + 7, 8) ln_phase(Y, a.in[I_LN1G] + l * DM, a.in[I_LN1B] + l * DM, X1, modl + 4 * 2048, modl + 3 * 2048, H, gw, ngw, lane);
        SEAM(pb + 7);
        PHASE(pb + 8, 9) { pg8::Gemm g{H, (const bf16_t*)(wl + WO_WGU), DM, DM, DM}; pg8::StaticOrder S; S.init(MTOK, NGU, G, bid);
            pg8::EpiGateUp E{ACT}; pg8::gemm_phase(lds, g, S, E, tid); }
        SEAM(pb + 8);
        PHASE(pb + 9, 10) { pg8::Gemm g{ACT, (const bf16_t*)(wl + WO_WD), DFF, DFF, DFF}; pg8::StaticOrder S; S.init(MTOK, DM, G, bid);
            pg8::EpiResid E{X1, modl + 5 * 2048, Y}; pg8::gemm_phase(lds, g, S, E, tid); }
        SEAM(pb + 9);
        PHASE(pb + 10, 11) { const float* modn = MOD + (size_t)(l + 1) * 4 * 12288;
            ln_phase(Y, a.in[I_LN2G] + l * DM, a.in[I_LN2B] + l * DM, a.out, l == 0 ? modn + 2048 : nullptr, l == 0 ? modn : nullptr, H, gw, ngw, lane); }
        if (l == 0) SEAM(pb + 10);
    }
#undef IN
#undef SEAM
}

#ifndef MK_SPLIT
#define MK_SPLIT 0
#endif
extern "C" void kernel_launch(void* const* d_in, const int* in_sizes, int n_in, void* d_out, int out_size, void* d_ws, size_t ws_size, hipStream_t stream) {
    static int grid = 0;
    if (grid == 0) {
        if (n_in != 30 || ws_size < WS_END) { fprintf(stderr, "kernel_launch: unexpected n_in %d or ws_size %zu (< %zu)\n", n_in, ws_size, (size_t)WS_END); grid = -1; return; }
        int dev = 0, cus = 0, per_cu = 0;
        hipGetDevice(&dev); hipDeviceGetAttribute(&cus, hipDeviceAttributeMultiprocessorCount, dev);
        if (hipFuncSetAttribute((const void*)mk_fwd, hipFuncAttributeMaxDynamicSharedMemorySize, LDS_BYTES) != hipSuccess) { fprintf(stderr, "kernel_launch: hipFuncSetAttribute failed\n"); grid = -1; return; }
        if (hipOccupancyMaxActiveBlocksPerMultiprocessor(&per_cu, (const void*)mk_fwd, 512, LDS_BYTES) != hipSuccess || per_cu < 1) { fprintf(stderr, "kernel_launch: occupancy query says %d\n", per_cu); per_cu = 1; }
        (void)hipGetLastError();
        grid = cus > 256 ? 256 : cus;
    }
    if (grid < 0) return;
    if (hipMemsetAsync((char*)d_ws + WS_CTL, 0, CTL_BYTES, stream) != hipSuccess) { fprintf(stderr, "memset failed\n"); return; }
    Args a{};
    for (int i = 0; i < 30; ++i) a.in[i] = (const float*)d_in[i];
    a.out = (float*)d_out; a.ws = (unsigned char*)d_ws;
#if MK_SPLIT
    for (int ph = 0; ph < NPH; ++ph) { a.ph_lo = ph; a.ph_hi = ph + 1; hipLaunchKernelGGL(mk_fwd, dim3(grid), dim3(512), LDS_BYTES, stream, a); }
#else
    a.ph_lo = 0; a.ph_hi = NPH;
    void* args[] = {&a};
    hipError_t e = hipLaunchCooperativeKernel((const void*)mk_fwd, dim3(grid), dim3(512), args, LDS_BYTES, stream);
    if (e != hipSuccess) fprintf(stderr, "cooperative launch failed: %s (grid %d)\n", hipGetErrorString(e), grid);
#endif
}
```

```cpp
#include <hip/hip_runtime.h>
#include <hip/hip_cooperative_groups.h>
#include <cstdio>
#include <cstdint>
namespace cg = cooperative_groups;

#define LAS __attribute__((address_space(3)))
typedef unsigned short bf16_t;
typedef short bf16x8 __attribute__((ext_vector_type(8)));
typedef short s16x4 __attribute__((ext_vector_type(4)));
typedef float f32x4 __attribute__((ext_vector_type(4)));
typedef unsigned u32x4 __attribute__((ext_vector_type(4)));
typedef unsigned u32x2 __attribute__((ext_vector_type(2)));

constexpr int DM = 2048, NB = 4, SEQ = 2048, MTOK = NB * SEQ, NPROJ = 18432, NIN = 18448, DFF = 5632, NGU = 2 * DFF;
constexpr int C_CVB = 0, C_CVC = 1024, C_CVX = 2048, C_S5U = 3072, C_SBQ = 4096, C_SBK = 5120, C_SBV = 6144, C_GLQ = 7168,
              C_GLK = 7680, C_GLV = 8192, C_GLR = 9216, C_GCONV = 10240, C_GS5 = 12288, C_GSB = 14336, C_GGLA = 16384;
constexpr int BR_CONV = 0, BR_S5 = 1024, BR_SB = 2048, BR_GLA = 3072, NBR = 4096;
constexpr float ALPHA = 1.41421356237f;
constexpr float QSCALE = 0.08838834764831845f;

constexpr size_t MiB = 1u << 20;
constexpr size_t W_LAYER = 167 * MiB;
constexpr size_t WO_WIN = 0, WO_WBR = 73 * MiB, WO_WO = 93 * MiB, WO_WGU = 101 * MiB, WO_WD = 145 * MiB;
constexpr size_t WS_W = 0;
constexpr size_t WS_S5M = 334 * MiB;
constexpr size_t S5_LAYER = 17 * MiB, S5O_MROW = 0, S5O_MIN = 12 * MiB, S5O_A16 = 16 * MiB;
constexpr size_t WS_MOD = 368 * MiB;
constexpr size_t WS_H = 369 * MiB;
constexpr size_t WS_PROJ = 401 * MiB;
constexpr size_t WS_ACT = WS_PROJ;
constexpr size_t WS_BR = 693 * MiB;
constexpr size_t WS_Y = 757 * MiB;
constexpr size_t WS_MB = 821 * MiB;
constexpr size_t WS_X1 = 853 * MiB;
constexpr size_t WS_SLOC = 917 * MiB;
constexpr size_t WS_SPREV = 933 * MiB;
constexpr size_t WS_BCUM = 941 * MiB;
constexpr size_t WS_AEND = 957 * MiB;
constexpr size_t WS_LR = WS_AEND + 512 * 1024;
constexpr size_t WS_LCT = 958 * MiB;
constexpr size_t WS_SNT = 1022 * MiB;
constexpr size_t WS_CTL = 1054 * MiB;
constexpr size_t CTL_BYTES = 16384;
constexpr size_t WS_END = 1055 * MiB;

constexpr int LDS_BYTES = 147456;

__device__ __forceinline__ float bf2f(unsigned u) { return __builtin_bit_cast(float, u << 16); }
__device__ __forceinline__ unsigned f2bf(float f) { unsigned u = __builtin_bit_cast(unsigned, f); return (u + 0x7fffu + ((u >> 16) & 1u)) >> 16; }
__device__ __forceinline__ unsigned pk2(float lo, float hi) { return f2bf(lo) | (f2bf(hi) << 16); }
__device__ __forceinline__ float lo16(unsigned w) { return __builtin_bit_cast(float, w << 16); }
__device__ __forceinline__ float hi16(unsigned w) { return __builtin_bit_cast(float, w & 0xffff0000u); }
__device__ __forceinline__ float sigm(float x) { return 1.f / (1.f + __expf(-x)); }
__device__ __forceinline__ float siluf_(float x) { return x / (1.f + __expf(-x)); }
__device__ __forceinline__ float gelu_tanh(float x) { float u = 0.7978845608028654f * (x + 0.044715f * x * x * x); float t = 1.f - 2.f / (1.f + __expf(2.f * u)); return 0.5f * x * (1.f + t); }
__device__ __forceinline__ float softplusf_(float z) { return fmaxf(z, 0.f) + __logf(1.f + __expf(-fabsf(z))); }
__device__ __forceinline__ float wave_sum(float v) {
#pragma unroll
    for (int o = 1; o < 64; o <<= 1) v += __shfl_xor(v, o);
    return v;
}
#define MFMA16(a, b, c) __builtin_amdgcn_mfma_f32_16x16x32_bf16((a), (b), (c), 0, 0, 0)

namespace pg8 {
constexpr int BM = 256, BK = 64, HALF = 128, HTB = HALF * BK * 2, NXCD = 8, WGM = 8;
__host__ __device__ __forceinline__ int lds_byte(int r, int c) { const int st = (r >> 4) * 2 + (c >> 5), rr = r & 15, cc = c & 31, ob = rr * 64 + cc * 2; return st * 1024 + (ob ^ (((ob >> 9) & 1) << 5)); }
__host__ __device__ __forceinline__ void stage_rc(int b, int& R, int& C) { const int st = b / 1024, sb = b % 1024, swz = sb ^ (((sb >> 9) & 1) << 5); R = (st >> 1) * 16 + swz / 64; C = (st & 1) * 32 + (swz % 64) / 2; }
__host__ __device__ __forceinline__ int perm32(int rho) { const int n = rho >> 4, i = rho & 15; return 8 * (i >> 2) + 4 * n + (i & 3); }

struct Unit { int pm, pn, acol, mode; };
struct Gemm { const bf16_t* A; const bf16_t* Bt; int lda, ldb, K; };

struct StaticOrder {
    int nM, nN, nwg, G, c, dup = 0;
    __device__ void init(int M, int N, int G_, int c_) { nM = M / BM; nN = N / BM; nwg = nM * nN; G = G_; c = c_; }
    __device__ bool next(int i, Unit& u) const {
        const long L = (long)(i >> dup) * G + c; if (L >= nwg) return false;
        int wgid = (int)L; { const int q = nwg / NXCD, r = nwg % NXCD, xcd = wgid % NXCD, off = wgid / NXCD; wgid = (xcd < r ? xcd * (q + 1) : r * (q + 1) + (xcd - r) * q) + off; }
        const int nig = WGM * nN, gid = wgid / nig, fm = gid * WGM, gsz = (nM - fm) < WGM ? (nM - fm) : WGM;
        u.pm = fm + ((wgid % nig) % gsz); u.pn = (wgid % nig) / gsz; u.acol = 0; u.mode = 0; return true;
    }
};
struct BranchOrder {
    int G, c, dup = 0;
    __device__ bool next(int i, Unit& u) const {
        const int L = ((i / 5) >> dup) * G + c; if (L >= 256) return false;
        const int sub = i % 5, pn8 = L & 7; u.pm = L >> 3;
        if (sub == 0) { u.pn = pn8; u.acol = BR_CONV; u.mode = 0; }
        else if (sub == 1) { u.pn = 8 + pn8; u.acol = BR_SB; u.mode = 1; }
        else if (sub == 2) { u.pn = 16 + pn8; u.acol = BR_GLA; u.mode = 2; }
        else { u.pn = 24 + 2 * pn8 + (sub - 3); u.acol = BR_S5; u.mode = 3; }
        return true;
    }
};

template <class Epi, class Sched>
__device__ __forceinline__ void gemm_phase(LAS unsigned char* lds, const Gemm g, const Sched& S, const Epi& E, int tid) {
    const int wid = __builtin_amdgcn_readfirstlane(tid >> 6), lane = tid & 63, wr = wid >> 2, wc = wid & 3, fr = lane & 15, fq = lane >> 4;
    const int K = g.K, nt = K / BK;
    unsigned voffA[2], voffB[2];
#pragma unroll
    for (int i = 0; i < 2; ++i) { int R, C; stage_rc(tid * 16 + i * 8192, R, C); const int Rb = (R & ~31) + perm32(R & 31);
        voffA[i] = (unsigned)(R * g.lda + C) * 2u; voffB[i] = (unsigned)(Rb * g.ldb + C) * 2u; }
    const size_t kstep = (size_t)(BK * 2);
    const size_t hstepA = (size_t)HALF * g.lda * 2, hstepB = (size_t)HALF * g.ldb * 2;
    const size_t tstepA = 2 * hstepA, tstepB = 2 * hstepB;
    const unsigned ldsw = (unsigned)wid * 1024u;
    const int aoff = lds_byte(wr * 64 + fr, fq * 8), boff = lds_byte(wc * 32 + fr, fq * 8);
#define PG8_SA(b, h) (((b) * 2 + (h)) * HTB)
#define PG8_SB(b, h) ((4 + (b) * 2 + (h)) * HTB)
#define PG8_STAGE(bufoff, gbase, voff) do { _Pragma("unroll") for (int _i = 0; _i < 2; ++_i) \
        __builtin_amdgcn_global_load_lds((const unsigned*)((const char*)(gbase) + (voff)[_i]), (LAS unsigned*)(lds + (bufoff) + ldsw + _i * 8192), 16, 0, 0); } while (0)
#define PG8_LDA(dst, b, h) do { _Pragma("unroll") for (int m = 0; m < 4; ++m) _Pragma("unroll") for (int k = 0; k < 2; ++k) dst[m][k] = *(const LAS bf16x8*)(lds + PG8_SA(b, h) + aoff + m * 2048 + k * 1024); } while (0)
#define PG8_LDB(dst, b, h) do { _Pragma("unroll") for (int n = 0; n < 2; ++n) _Pragma("unroll") for (int k = 0; k < 2; ++k) dst[n][k] = *(const LAS bf16x8*)(lds + PG8_SB(b, h) + boff + n * 2048 + k * 1024); } while (0)
#define PG8_MMA(ai, bj, At, Bt) do { __builtin_amdgcn_s_setprio(1); _Pragma("unroll") for (int m = 0; m < 4; ++m) _Pragma("unroll") for (int n = 0; n < 2; ++n) _Pragma("unroll") for (int k = 0; k < 2; ++k) \
        acc[ai][bj][m][n] = __builtin_amdgcn_mfma_f32_16x16x32_bf16(Bt[n][k], At[m][k], acc[ai][bj][m][n], 0, 0, 0); __builtin_amdgcn_s_setprio(0); } while (0)
#define PG8_WAIT_V(n) asm volatile("s_waitcnt vmcnt(" #n ")" ::: "memory")
#define PG8_WAIT_L(n) asm volatile("s_waitcnt lgkmcnt(" #n ")" ::: "memory")
#define PG8_BAR __builtin_amdgcn_s_barrier()
#define PG8_SCHED __builtin_amdgcn_sched_barrier(0)
    Unit cur, nxt; int ui = 0;
    if (!S.next(0, cur)) return;
    f32x4 acc[2][2][4][2];
#pragma unroll
    for (int a = 0; a < 2; ++a)
#pragma unroll
        for (int b = 0; b < 2; ++b)
#pragma unroll
            for (int m = 0; m < 4; ++m)
#pragma unroll
                for (int n = 0; n < 2; ++n) acc[a][b][m][n] = (f32x4){0.f, 0.f, 0.f, 0.f};
    bf16x8 At[4][2], B0[2][2], B1[2][2];
    const char* cA = (const char*)g.A + (size_t)cur.pm * tstepA + (size_t)cur.acol * 2; const char* cB = (const char*)g.Bt + (size_t)cur.pn * tstepB;
    PG8_STAGE(PG8_SB(0, 0), cB, voffB); PG8_STAGE(PG8_SB(0, 1), cB + hstepB, voffB); PG8_STAGE(PG8_SA(0, 0), cA, voffA); PG8_STAGE(PG8_SA(0, 1), cA + hstepA, voffA);
    if (wr == 1) PG8_BAR;
    PG8_WAIT_V(2); PG8_BAR;
    PG8_STAGE(PG8_SB(1, 0), cB + kstep, voffB); PG8_STAGE(PG8_SA(1, 0), cA + kstep, voffA); PG8_STAGE(PG8_SB(1, 1), cB + hstepB + kstep, voffB);
    PG8_WAIT_V(6); PG8_BAR;
    for (;;) {
        const bool has_next = S.next(ui + 1, nxt);
        const char* nA = has_next ? (const char*)g.A + (size_t)nxt.pm * tstepA + (size_t)nxt.acol * 2 : cA; const char* nB = has_next ? (const char*)g.Bt + (size_t)nxt.pn * tstepB : cB;
        for (int t = 0; t < nt; t += 2) {
            const bool last = (t == nt - 2);
            const char* a1 = cA + (size_t)(t + 1) * kstep;
            const char* a2 = last ? nA : cA + (size_t)(t + 2) * kstep; const char* b2 = last ? nB : cB + (size_t)(t + 2) * kstep;
            const char* a3 = a2 + kstep; const char* b3 = b2 + kstep;
            PG8_LDB(B0, 0, 0); PG8_LDB(B1, 0, 1); PG8_SCHED; PG8_LDA(At, 0, 0); PG8_STAGE(PG8_SA(1, 1), a1 + hstepA, voffA);
            PG8_WAIT_V(8); PG8_WAIT_L(0); PG8_BAR; PG8_MMA(0, 0, At, B0); PG8_MMA(0, 1, At, B1); PG8_BAR; PG8_SCHED;
            PG8_LDA(At, 0, 1); PG8_STAGE(PG8_SB(0, 0), b2, voffB); PG8_STAGE(PG8_SB(0, 1), b2 + hstepB, voffB); PG8_STAGE(PG8_SA(0, 0), a2, voffA);
            PG8_WAIT_V(8); PG8_WAIT_L(0); PG8_BAR; PG8_MMA(1, 0, At, B0); PG8_MMA(1, 1, At, B1); PG8_BAR; PG8_SCHED;
            PG8_LDB(B0, 1, 0); PG8_LDB(B1, 1, 1); PG8_SCHED; PG8_LDA(At, 1, 0); PG8_STAGE(PG8_SA(0, 1), a2 + hstepA, voffA);
            PG8_WAIT_V(8); PG8_WAIT_L(0); PG8_BAR; PG8_MMA(0, 0, At, B0); PG8_MMA(0, 1, At, B1); PG8_BAR; PG8_SCHED;
            PG8_LDA(At, 1, 1); PG8_STAGE(PG8_SB(1, 0), b3, voffB); PG8_STAGE(PG8_SB(1, 1), b3 + hstepB, voffB); PG8_STAGE(PG8_SA(1, 0), a3, voffA);
            PG8_WAIT_V(8); PG8_WAIT_L(0); PG8_BAR; PG8_MMA(1, 0, At, B0); PG8_MMA(1, 1, At, B1); PG8_BAR; PG8_SCHED;
        }
        E(acc, cur, wr, wc, fr, fq);
        if (!has_next) break;
#pragma unroll
        for (int a = 0; a < 2; ++a)
#pragma unroll
            for (int b = 0; b < 2; ++b)
#pragma unroll
                for (int m = 0; m < 4; ++m)
#pragma unroll
                    for (int n = 0; n < 2; ++n) acc[a][b][m][n] = (f32x4){0.f, 0.f, 0.f, 0.f};
        cur = nxt; cA = nA; cB = nB; ++ui;
    }
    PG8_WAIT_V(0);
    if (wr == 0) PG8_BAR;
    PG8_BAR;
#undef PG8_SA
#undef PG8_SB
#undef PG8_STAGE
#undef PG8_LDA
#undef PG8_LDB
#undef PG8_MMA
#undef PG8_WAIT_V
#undef PG8_WAIT_L
#undef PG8_BAR
#undef PG8_SCHED
}

struct EpiBf16 {
    bf16_t* O; int ldc;
    __device__ __forceinline__ void operator()(const f32x4 (&acc)[2][2][4][2], const Unit& u, int wr, int wc, int fr, int fq) const {
        const int row0 = u.pm * BM + wr * 64 + fr, col0 = u.pn * BM + wc * 32 + 8 * fq;
#pragma unroll
        for (int ai = 0; ai < 2; ++ai)
#pragma unroll
            for (int m = 0; m < 4; ++m) { bf16_t* rowp = O + (size_t)(row0 + ai * HALF + m * 16) * ldc + col0;
#pragma unroll
                for (int bj = 0; bj < 2; ++bj) { const f32x4 v0 = acc[ai][bj][m][0], v1 = acc[ai][bj][m][1];
                    u32x4 w; w.x = pk2(v0[0], v0[1]); w.y = pk2(v0[2], v0[3]); w.z = pk2(v1[0], v1[1]); w.w = pk2(v1[2], v1[3]);
                    *(u32x4*)(rowp + bj * HALF) = w; } }
    }
};
struct EpiGateUp {
    bf16_t* O;
    __device__ __forceinline__ void operator()(const f32x4 (&acc)[2][2][4][2], const Unit& u, int wr, int wc, int fr, int fq) const {
        const int row0 = u.pm * BM + wr * 64 + fr, col0 = u.pn * HALF + wc * 32 + 8 * fq;
#pragma unroll
        for (int ai = 0; ai < 2; ++ai)
#pragma unroll
            for (int m = 0; m < 4; ++m) { bf16_t* rowp = O + (size_t)(row0 + ai * HALF + m * 16) * DFF + col0;
                float r[8];
#pragma unroll
                for (int n = 0; n < 2; ++n)
#pragma unroll
                    for (int i = 0; i < 4; ++i) r[n * 4 + i] = siluf_(acc[ai][0][m][n][i]) * acc[ai][1][m][n][i];
                u32x4 w; w.x = pk2(r[0], r[1]); w.y = pk2(r[2], r[3]); w.z = pk2(r[4], r[5]); w.w = pk2(r[6], r[7]);
                *(u32x4*)rowp = w; }
    }
};
struct EpiResid {
    const float* X; const float* gate; float* Y;
    __device__ __forceinline__ void operator()(const f32x4 (&acc)[2][2][4][2], const Unit& u, int wr, int wc, int fr, int fq) const {
        const int row0 = u.pm * BM + wr * 64 + fr, col0 = u.pn * BM + wc * 32 + 8 * fq;
        const float* gp = gate + (size_t)(u.pm >> 3) * 12288 + col0;
#pragma unroll
        for (int bj = 0; bj < 2; ++bj) {
            const f32x4 g0 = *(const f32x4*)(gp + bj * HALF), g1 = *(const f32x4*)(gp + bj * HALF + 4);
#pragma unroll
            for (int ai = 0; ai < 2; ++ai) {
                f32x4 x0[4], x1[4];
#pragma unroll
                for (int m = 0; m < 4; ++m) { const size_t off = (size_t)(row0 + ai * HALF + m * 16) * DM + col0 + bj * HALF;
                    x0[m] = *(const f32x4*)(X + off); x1[m] = *(const f32x4*)(X + off + 4); }
#pragma unroll
                for (int m = 0; m < 4; ++m) { const size_t off = (size_t)(row0 + ai * HALF + m * 16) * DM + col0 + bj * HALF;
                    *(f32x4*)(Y + off) = x0[m] * ALPHA + g0 * acc[ai][bj][m][0];
                    *(f32x4*)(Y + off + 4) = x1[m] * ALPHA + g1 * acc[ai][bj][m][1]; }
            }
        }
    }
};
struct EpiBranch {
    const bf16_t* P; float* MG; bf16_t* MBF;
    __device__ __forceinline__ void operator()(const f32x4 (&acc)[2][2][4][2], const Unit& u, int wr, int wc, int fr, int fq) const {
        const int row0 = u.pm * BM + wr * 64 + fr;
        if (u.mode < 3) {
            const int col0 = u.pn * BM - u.mode * 2048 + wc * 32 + 8 * fq;
            const int gcol = (u.mode == 0 ? C_GCONV : (u.mode == 1 ? C_GSB : C_GGLA));
            const bool rmw = u.mode != 0;
#pragma unroll
            for (int ai = 0; ai < 2; ++ai)
#pragma unroll
                for (int mh = 0; mh < 2; ++mh) {
                    u32x4 gw[2][2]; f32x4 m0[2][2], m1[2][2];
#pragma unroll
                    for (int mm = 0; mm < 2; ++mm)
#pragma unroll
                        for (int bj = 0; bj < 2; ++bj) { const int row = row0 + ai * HALF + (2 * mh + mm) * 16, c = col0 + bj * HALF;
                            gw[mm][bj] = *(const u32x4*)(P + (size_t)row * NPROJ + gcol + c);
                            if (rmw) { const float* mp = MG + (size_t)row * DM + c; m0[mm][bj] = *(const f32x4*)mp; m1[mm][bj] = *(const f32x4*)(mp + 4); }
                            else { m0[mm][bj] = (f32x4){0.f, 0.f, 0.f, 0.f}; m1[mm][bj] = (f32x4){0.f, 0.f, 0.f, 0.f}; } }
#pragma unroll
                    for (int mm = 0; mm < 2; ++mm)
#pragma unroll
                        for (int bj = 0; bj < 2; ++bj) { const int m = 2 * mh + mm; const int row = row0 + ai * HALF + m * 16, c = col0 + bj * HALF;
                            const u32x4 g = gw[mm][bj]; f32x4 r0 = m0[mm][bj], r1 = m1[mm][bj];
                            r0[0] += sigm(lo16(g.x)) * acc[ai][bj][m][0][0]; r0[1] += sigm(hi16(g.x)) * acc[ai][bj][m][0][1];
                            r0[2] += sigm(lo16(g.y)) * acc[ai][bj][m][0][2]; r0[3] += sigm(hi16(g.y)) * acc[ai][bj][m][0][3];
                            r1[0] += sigm(lo16(g.z)) * acc[ai][bj][m][1][0]; r1[1] += sigm(hi16(g.z)) * acc[ai][bj][m][1][1];
                            r1[2] += sigm(lo16(g.w)) * acc[ai][bj][m][1][2]; r1[3] += sigm(hi16(g.w)) * acc[ai][bj][m][1][3];
                            float* mp = MG + (size_t)row * DM + c; *(f32x4*)mp = r0; *(f32x4*)(mp + 4) = r1; }
                }
        } else {
            const int col0 = (u.pn - 24) * HALF + wc * 32 + 8 * fq;
#pragma unroll
            for (int ai = 0; ai < 2; ++ai) {
                u32x4 gw[4]; f32x4 m0[4], m1[4];
#pragma unroll
                for (int m = 0; m < 4; ++m) { const int row = row0 + ai * HALF + m * 16;
                    gw[m] = *(const u32x4*)(P + (size_t)row * NPROJ + C_GS5 + col0);
                    const float* mp = MG + (size_t)row * DM + col0; m0[m] = *(const f32x4*)mp; m1[m] = *(const f32x4*)(mp + 4); }
#pragma unroll
                for (int m = 0; m < 4; ++m) { const int row = row0 + ai * HALF + m * 16; const u32x4 g = gw[m];
                    float r[8];
                    r[0] = m0[m][0] + sigm(lo16(g.x)) * acc[ai][0][m][0][0] * sigm(acc[ai][1][m][0][0]);
                    r[1] = m0[m][1] + sigm(hi16(g.x)) * acc[ai][0][m][0][1] * sigm(acc[ai][1][m][0][1]);
                    r[2] = m0[m][2] + sigm(lo16(g.y)) * acc[ai][0][m][0][2] * sigm(acc[ai][1][m][0][2]);
                    r[3] = m0[m][3] + sigm(hi16(g.y)) * acc[ai][0][m][0][3] * sigm(acc[ai][1][m][0][3]);
                    r[4] = m1[m][0] + sigm(lo16(g.z)) * acc[ai][0][m][1][0] * sigm(acc[ai][1][m][1][0]);
                    r[5] = m1[m][1] + sigm(hi16(g.z)) * acc[ai][0][m][1][1] * sigm(acc[ai][1][m][1][1]);
                    r[6] = m1[m][2] + sigm(lo16(g.w)) * acc[ai][0][m][1][2] * sigm(acc[ai][1][m][1][2]);
                    r[7] = m1[m][3] + sigm(hi16(g.w)) * acc[ai][0][m][1][3] * sigm(acc[ai][1][m][1][3]);
                    u32x4 w; w.x = pk2(r[0], r[1]); w.y = pk2(r[2], r[3]); w.z = pk2(r[4], r[5]); w.w = pk2(r[6], r[7]);
                    *(u32x4*)(MBF + (size_t)row * DM + col0) = w; }
            }
        }
    }
};
}

struct Args { const float* in[30]; float* out; unsigned char* ws; int ph_lo, ph_hi; };
enum { I_X = 0, I_C, I_ADAW, I_ADAB, I_WIN, I_CONVW, I_WCO, I_LRE, I_LIM, I_BRE, I_BIM, I_CRE, I_CIM, I_S5D, I_LOGDT, I_WS5V, I_WS5G, I_WSB,
       I_GLAWG, I_GLABG, I_GLANG, I_WGLA, I_WO, I_LN1G, I_LN1B, I_FFG, I_FFU, I_FFD, I_LN2G, I_LN2B };

__device__ __forceinline__ void tr_item(const float* srcp, int ld, int k0, bf16_t* WT, int Kd, int n0, float* scr, int lane) {
    const int r4 = lane >> 4, n4 = (lane & 15) * 4;
    f32x4 v[16];
#pragma unroll
    for (int i = 0; i < 16; ++i) v[i] = srcp ? *(const f32x4*)(srcp + (size_t)(k0 + 4 * i + r4) * ld) : (f32x4){0.f, 0.f, 0.f, 0.f};
#pragma unroll
    for (int i = 0; i < 16; ++i) { float* d = scr + (4 * i + r4) * 65 + n4; d[0] = v[i][0]; d[1] = v[i][1]; d[2] = v[i][2]; d[3] = v[i][3]; }
    __builtin_amdgcn_s_waitcnt(0); asm volatile("" ::: "memory");
    const int c = lane & 7;
#pragma unroll
    for (int j = 0; j < 8; ++j) { const int n = (lane >> 3) + 8 * j; const float* s = scr + (8 * c) * 65 + n;
        u32x4 o; o.x = pk2(s[0 * 65], s[1 * 65]); o.y = pk2(s[2 * 65], s[3 * 65]); o.z = pk2(s[4 * 65], s[5 * 65]); o.w = pk2(s[6 * 65], s[7 * 65]);
        *(u32x4*)(WT + (size_t)(n0 + n) * Kd + k0 + 8 * c) = o; }
    __builtin_amdgcn_s_waitcnt(0); asm volatile("" ::: "memory");
}

__device__ __forceinline__ void p0_transposes(const Args& a, unsigned char* smem, int gw, int ngw, int wave, int lane) {
    float* scr = (float*)(smem + wave * 16640);
    constexpr int C0 = 32 * 289, C1 = 16 * 160, C2 = 32 * 32, C3 = 32 * 176, C4 = 88 * 32, CL = C0 + C1 + C2 + C3 + C4;
    for (int it = gw; it < 2 * CL; it += ngw) {
        const int l = it / CL; int r = it % CL;
        unsigned char* wl = a.ws + WS_W + (size_t)l * W_LAYER;
        const int nl = (lane & 15) * 4;
        if (r < C0) { const int kb = r / 289, nb = r % 289, j = nb * 64 + nl;
            const float* base = a.in[I_WIN] + (size_t)l * DM * NIN;
            const float* sp = j < 10240 ? base + j : (j < 18432 ? base + j + 16 : (j < 18448 ? base + (j - 8192) : nullptr));
            tr_item(sp, NIN, kb * 64, (bf16_t*)(wl + WO_WIN), DM, nb * 64, scr, lane); continue; }
        r -= C0;
        if (r < C1) { const int kb = r / 160, nb = r % 160, j = nb * 64 + nl; const float* sp;
            if (j < 2048) sp = a.in[I_WCO] + (size_t)l * 1024 * DM + j;
            else if (j < 4096) sp = a.in[I_WSB] + (size_t)l * 1024 * DM + (j - 2048);
            else if (j < 6144) sp = a.in[I_WGLA] + (size_t)l * 1024 * DM + (j - 4096);
            else { const int rr = j - 6144, tile = rr >> 8, w = rr & 255; sp = (w < 128 ? a.in[I_WS5V] : a.in[I_WS5G]) + (size_t)l * 1024 * DM + tile * 128 + (w & 127); }
            tr_item(sp, DM, kb * 64, (bf16_t*)(wl + WO_WBR), 1024, nb * 64, scr, lane); continue; }
        r -= C1;
        if (r < C2) { const int kb = r / 32, nb = r % 32, j = nb * 64 + nl;
            tr_item(a.in[I_WO] + (size_t)l * DM * DM + j, DM, kb * 64, (bf16_t*)(wl + WO_WO), DM, nb * 64, scr, lane); continue; }
        r -= C2;
        if (r < C3) { const int kb = r / 176, nb = r % 176, j = nb * 64 + nl; const int tile = j >> 8, w = j & 255;
            const float* sp = (w < 128 ? a.in[I_FFG] : a.in[I_FFU]) + (size_t)l * DM * DFF + tile * 128 + (w & 127);
            tr_item(sp, DFF, kb * 64, (bf16_t*)(wl + WO_WGU), DM, nb * 64, scr, lane); continue; }
        r -= C3;
        { const int kb = r / 32, nb = r % 32, j = nb * 64 + nl;
            tr_item(a.in[I_FFD] + (size_t)l * DFF * DM + j, DM, kb * 64, (bf16_t*)(wl + WO_WD), DFF, nb * 64, scr, lane); }
    }
}

__device__ __forceinline__ void p0_adaln_item(const Args& a, unsigned char* smem, int item, int tid) {
    const int lane = tid & 63, w = tid >> 6;
    float* sc = (float*)smem;
    float* red = (float*)(smem + 32768);
    const int l = item / 192, col0 = (item % 192) * 64;
    const float* wp = a.in[I_ADAW] + (size_t)l * DM * 12288 + col0 + lane;
    float acc0 = 0.f, acc1 = 0.f, acc2 = 0.f, acc3 = 0.f;
    const int k0 = w * 256;
#pragma unroll 8
    for (int k = k0; k < k0 + 256; ++k) { const float wv = wp[(size_t)k * 12288];
        acc0 += sc[k] * wv; acc1 += sc[2048 + k] * wv; acc2 += sc[4096 + k] * wv; acc3 += sc[6144 + k] * wv; }
    red[(w * 4 + 0) * 64 + lane] = acc0; red[(w * 4 + 1) * 64 + lane] = acc1; red[(w * 4 + 2) * 64 + lane] = acc2; red[(w * 4 + 3) * 64 + lane] = acc3;
    __syncthreads();
    if (tid < 256) { const int b = tid >> 6, col = tid & 63; float s = a.in[I_ADAB][l * 12288 + col0 + col];
#pragma unroll
        for (int ww = 0; ww < 8; ++ww) s += red[(ww * 4 + b) * 64 + col];
        ((float*)(a.ws + WS_MOD))[(size_t)(l * 4 + b) * 12288 + col0 + col] = s; }
    __syncthreads();
}

__device__ __forceinline__ void p0_s5pre_item(const Args& a, unsigned char* smem, int item, int tid) {
    const int l = item >> 6, g = item & 63, lg = l * 64 + g;
    float2* Bb = (float2*)(smem + 40960);
    float2* Cc = Bb + 1024;
    float2* Pw = Cc + 1024;
    float* Kt = (float*)(Pw + 17 * 64);
    float2* Ff = (float2*)(Kt + 4096);
    unsigned char* s5w = a.ws + WS_S5M + (size_t)l * S5_LAYER;
    if (tid < 64) { const int p = tid;
        const double dt = exp((double)a.in[I_LOGDT][lg]);
        const double lr = (double)a.in[I_LRE][lg * 64 + p], li = (double)a.in[I_LIM][lg * 64 + p];
        const double rev = li * dt * 0.15915494309189535;
        double abr = 0.0, abi = 0.0;
        for (int tau = 0; tau <= 16; ++tau) { const double mg = exp(lr * dt * tau); double x = rev * tau; x -= rint(x);
            const double s = sinpi(2.0 * x), c = cospi(2.0 * x);
            Pw[tau * 64 + p] = make_float2((float)(mg * c), (float)(mg * s));
            if (tau == 1) { abr = mg * c; abi = mg * s; } }
        const double den = lr * lr + li * li, nr = abr - 1.0, ni = abi;
        Ff[p] = make_float2((float)((nr * lr + ni * li) / den), (float)((ni * lr - nr * li) / den));
        ((float2*)(s5w + S5O_A16))[g * 64 + p] = Pw[16 * 64 + p];
    }
    __syncthreads();
    for (int e = tid; e < 1024; e += 512) { const int p = e >> 4;
        const float br = a.in[I_BRE][(size_t)lg * 1024 + e], bi = a.in[I_BIM][(size_t)lg * 1024 + e]; const float2 f = Ff[p];
        Bb[e] = make_float2(f.x * br - f.y * bi, f.x * bi + f.y * br);
        Cc[e] = make_float2(a.in[I_CRE][(size_t)lg * 1024 + e], a.in[I_CIM][(size_t)lg * 1024 + e]); }
    __syncthreads();
    for (int idx = tid; idx < 4096; idx += 512) { const int tau = idx >> 8, h = (idx >> 4) & 15, hp = idx & 15; float s = 0.f;
        for (int p = 0; p < 64; ++p) { const float2 c = Cc[h * 64 + p], w = Pw[tau * 64 + p], b = Bb[p * 16 + hp];
            const float cr = c.x * w.x - c.y * w.y, ci = c.x * w.y + c.y * w.x; s += cr * b.x - ci * b.y; }
        Kt[idx] = s; }
    __syncthreads();
    {
        bf16_t* MR = (bf16_t*)(s5w + S5O_MROW) + (size_t)g * 256 * 384;
        for (int e2 = tid; e2 < 256 * 192; e2 += 512) { const int n = e2 / 192, k2 = (e2 % 192) * 2; const int i = n >> 4, h = n & 15; float v[2];
#pragma unroll
            for (int u = 0; u < 2; ++u) { const int k = k2 + u;
                if (k < 256) { const int j = k >> 4, hp = k & 15; v[u] = (i >= j) ? Kt[(i - j) * 256 + h * 16 + hp] : 0.f; }
                else if (k < 320) { const int p = k - 256; const float2 c = Cc[h * 64 + p], w = Pw[(i + 1) * 64 + p]; v[u] = c.x * w.x - c.y * w.y; }
                else { const int p = k - 320; const float2 c = Cc[h * 64 + p], w = Pw[(i + 1) * 64 + p]; v[u] = -(c.x * w.y + c.y * w.x); } }
            *(unsigned*)(MR + (size_t)n * 384 + k2) = pk2(v[0], v[1]); }
        bf16_t* MI = (bf16_t*)(s5w + S5O_MIN) + (size_t)g * 128 * 256;
        for (int e2 = tid; e2 < 128 * 128; e2 += 512) { const int n2 = e2 >> 7, k2 = (e2 & 127) * 2; const int p = n2 & 63; float v[2];
#pragma unroll
            for (int u = 0; u < 2; ++u) { const int k = k2 + u, j = k >> 4, hp = k & 15; const float2 w = Pw[(15 - j) * 64 + p], b = Bb[p * 16 + hp];
                v[u] = (n2 < 64) ? (w.x * b.x - w.y * b.y) : (w.x * b.y + w.y * b.x); }
            *(unsigned*)(MI + (size_t)n2 * 256 + k2) = pk2(v[0], v[1]); }
    }
    __syncthreads();
}

__device__ __forceinline__ void ln_stats(const f32x4 (&v)[8], float& mean, float& rstd) {
    float s = 0.f;
#pragma unroll
    for (int j = 0; j < 8; ++j) s += (v[j][0] + v[j][1]) + (v[j][2] + v[j][3]);
    mean = wave_sum(s) * (1.f / DM); float q = 0.f;
#pragma unroll
    for (int j = 0; j < 8; ++j) { const f32x4 d = v[j] - mean; q += (d[0] * d[0] + d[1] * d[1]) + (d[2] * d[2] + d[3] * d[3]); }
    rstd = rsqrtf(wave_sum(q) * (1.f / DM) + 1e-5f);
}
__device__ __forceinline__ void ln_mod_store(const f32x4 (&v)[8], const float* sc, const float* sh, bf16_t* hrow, int lane) {
    float mean, rstd; ln_stats(v, mean, rstd);
#pragma unroll
    for (int j = 0; j < 8; ++j) { const int c = 4 * lane + 256 * j; const f32x4 s = *(const f32x4*)(sc + c), t = *(const f32x4*)(sh + c);
        const f32x4 y = (v[j] - mean) * rstd * (s + 1.f) + t; u32x2 w; w.x = pk2(y[0], y[1]); w.y = pk2(y[2], y[3]); *(u32x2*)(hrow + c) = w; }
}
__device__ __forceinline__ void ln_phase(const float* in, const float* g, const float* bta, float* xo, const float* modsc, const float* modsh, bf16_t* H, int gw, int ngw, int lane) {
    for (int m = gw; m < MTOK; m += ngw) {
        f32x4 v[8];
#pragma unroll
        for (int j = 0; j < 8; ++j) v[j] = *(const f32x4*)(in + (size_t)m * DM + 4 * lane + 256 * j);
        if (g) { float mean, rstd; ln_stats(v, mean, rstd);
#pragma unroll
            for (int j = 0; j < 8; ++j) { const int c = 4 * lane + 256 * j; const f32x4 gg = *(const f32x4*)(g + c), bb = *(const f32x4*)(bta + c);
                v[j] = (v[j] - mean) * rstd * gg + bb; *(f32x4*)(xo + (size_t)m * DM + c) = v[j]; } }
        if (modsc) { const int b = m >> 11; ln_mod_store(v, modsc + (size_t)b * 12288, modsh + (size_t)b * 12288, H + (size_t)m * DM, lane); }
    }
}

__device__ __forceinline__ void conv_item(const bf16_t* P, bf16_t* BR, const float* cw, int it, int tid) {
    const int idx = it * 512 + tid, m = idx >> 7, c8 = (idx & 127) * 8, t = m & (SEQ - 1);
    const bf16_t* pr = P + (size_t)m * NPROJ;
    float accv[8];
#pragma unroll
    for (int i = 0; i < 8; ++i) accv[i] = 0.f;
#pragma unroll
    for (int j = 0; j < 3; ++j) { const int dtk = 2 - j; if (t - dtk < 0) continue;
        const bf16_t* pj = pr - (size_t)dtk * NPROJ;
        const u32x4 cc = *(const u32x4*)(pj + C_CVC + c8), xx = *(const u32x4*)(pj + C_CVX + c8);
        const f32x4 w0 = *(const f32x4*)(cw + j * 1024 + c8), w1 = *(const f32x4*)(cw + j * 1024 + c8 + 4);
        accv[0] += w0[0] * lo16(cc.x) * lo16(xx.x); accv[1] += w0[1] * hi16(cc.x) * hi16(xx.x);
        accv[2] += w0[2] * lo16(cc.y) * lo16(xx.y); accv[3] += w0[3] * hi16(cc.y) * hi16(xx.y);
        accv[4] += w1[0] * lo16(cc.z) * lo16(xx.z); accv[5] += w1[1] * hi16(cc.z) * hi16(xx.z);
        accv[6] += w1[2] * lo16(cc.w) * lo16(xx.w); accv[7] += w1[3] * hi16(cc.w) * hi16(xx.w); }
    const u32x4 bb = *(const u32x4*)(pr + C_CVB + c8);
    u32x4 o; o.x = pk2(accv[0] * lo16(bb.x), accv[1] * hi16(bb.x)); o.y = pk2(accv[2] * lo16(bb.y), accv[3] * hi16(bb.y));
    o.z = pk2(accv[4] * lo16(bb.z), accv[5] * hi16(bb.z)); o.w = pk2(accv[6] * lo16(bb.w), accv[7] * hi16(bb.w));
    *(u32x4*)(BR + (size_t)m * NBR + BR_CONV + c8) = o;
}

__device__ __forceinline__ void lr_item(const bf16_t* Hh, const bf16_t* Wlr, float* LR, int it, int lane) {
    const int c16 = lane & 15, q = lane >> 4;
    const bf16_t* ap = Hh + (size_t)(16 * it + c16) * DM + 8 * q; const bf16_t* bp = Wlr + (size_t)c16 * DM + 8 * q;
    f32x4 acc = {0.f, 0.f, 0.f, 0.f};
#pragma unroll 1
    for (int k0 = 0; k0 < 64; k0 += 8) { bf16x8 af[8], bfr[8];
#pragma unroll
        for (int u = 0; u < 8; ++u) { af[u] = *(const bf16x8*)(ap + 32 * (k0 + u)); bfr[u] = *(const bf16x8*)(bp + 32 * (k0 + u)); }
#pragma unroll
        for (int u = 0; u < 8; ++u) acc = MFMA16(af[u], bfr[u], acc); }
#pragma unroll
    for (int j = 0; j < 4; ++j) LR[(size_t)(16 * it + 4 * q + j) * 16 + c16] = acc[j];
}

__device__ __forceinline__ void s5a_item(const bf16_t* P, const bf16_t* MIN, float* SLOC, int wi, int lane) {
    const int g = wi >> 5, ct = wi & 31, c16 = lane & 15, q = lane >> 4;
    const int cc = ct * 16 + c16, b = cc >> 7, c = cc & 127;
    bf16x8 bf[8];
#pragma unroll
    for (int ks = 0; ks < 8; ++ks) bf[ks] = *(const bf16x8*)(P + (size_t)(b * SEQ + c * 16 + 2 * ks + (q >> 1)) * NPROJ + C_S5U + g * 16 + (q & 1) * 8);
    const bf16_t* Mg = MIN + (size_t)g * 128 * 256;
    float* out = SLOC + ((size_t)(b * 128 + c) * 64 + g) * 128;
#pragma unroll
    for (int rt = 0; rt < 8; ++rt) { f32x4 acc = {0.f, 0.f, 0.f, 0.f};
#pragma unroll
        for (int ks = 0; ks < 8; ++ks) { const bf16x8 af = *(const bf16x8*)(Mg + (size_t)(16 * rt + c16) * 256 + 32 * ks + 8 * q); acc = MFMA16(af, bf[ks], acc); }
        *(f32x4*)(out + 16 * rt + 4 * q) = acc; }
}

__device__ __forceinline__ void s5c_item(const bf16_t* P, const bf16_t* MROW, const bf16_t* SPREV, const float* dsk, bf16_t* BR, int wi, int lane) {
    const int g = wi >> 5, ct = wi & 31, c16 = lane & 15, q = lane >> 4;
    const int cc = ct * 16 + c16, b = cc >> 7, c = cc & 127;
    bf16x8 bf[12];
#pragma unroll
    for (int ks = 0; ks < 8; ++ks) bf[ks] = *(const bf16x8*)(P + (size_t)(b * SEQ + c * 16 + 2 * ks + (q >> 1)) * NPROJ + C_S5U + g * 16 + (q & 1) * 8);
    const bf16_t* sp = SPREV + ((size_t)(b * 128 + c) * 64 + g) * 128;
#pragma unroll
    for (int ks = 0; ks < 4; ++ks) bf[8 + ks] = *(const bf16x8*)(sp + 32 * ks + 8 * q);
    const bf16_t* Mg = MROW + (size_t)g * 256 * 384;
    const f32x4 dv = *(const f32x4*)(dsk + g * 16 + 4 * q);
#pragma unroll
    for (int i = 0; i < 16; ++i) { f32x4 acc = {0.f, 0.f, 0.f, 0.f};
        const bf16_t* mrow = Mg + (size_t)(16 * i + c16) * 384 + 8 * q;
#pragma unroll
        for (int ks = 0; ks < 8; ++ks) if (ks <= (i >> 1)) { const bf16x8 af = *(const bf16x8*)(mrow + 32 * ks); acc = MFMA16(af, bf[ks], acc); }
#pragma unroll
        for (int ks = 8; ks < 12; ++ks) { const bf16x8 af = *(const bf16x8*)(mrow + 32 * ks); acc = MFMA16(af, bf[ks], acc); }
        const size_t m = (size_t)b * SEQ + c * 16 + i;
        const u32x2 uw = *(const u32x2*)(P + m * NPROJ + C_S5U + g * 16 + 4 * q);
        const float y0 = acc[0] + dv[0] * lo16(uw.x), y1 = acc[1] + dv[1] * hi16(uw.x), y2 = acc[2] + dv[2] * lo16(uw.y), y3 = acc[3] + dv[3] * hi16(uw.y);
        u32x2 o; o.x = pk2(gelu_tanh(y0), gelu_tanh(y1)); o.y = pk2(gelu_tanh(y2), gelu_tanh(y3));
        *(u32x2*)(BR + m * NBR + BR_S5 + g * 16 + 4 * q) = o; }
}

__device__ __forceinline__ void stage_vt64(const bf16_t* P, size_t m0, int vcol0, bf16_t* VT, int tid) {
#pragma unroll
    for (int i = 0; i < 4; ++i) { const int id = tid + 512 * i, t = id >> 5, v8 = (id & 31) * 8;
        const u32x4 vv = *(const u32x4*)(P + (m0 + t) * NPROJ + vcol0 + v8);
        VT[(v8 + 0) * 72 + t] = (bf16_t)(vv.x & 0xffffu); VT[(v8 + 1) * 72 + t] = (bf16_t)(vv.x >> 16);
        VT[(v8 + 2) * 72 + t] = (bf16_t)(vv.y & 0xffffu); VT[(v8 + 3) * 72 + t] = (bf16_t)(vv.y >> 16);
        VT[(v8 + 4) * 72 + t] = (bf16_t)(vv.z & 0xffffu); VT[(v8 + 5) * 72 + t] = (bf16_t)(vv.z >> 16);
        VT[(v8 + 6) * 72 + t] = (bf16_t)(vv.w & 0xffffu); VT[(v8 + 7) * 72 + t] = (bf16_t)(vv.w >> 16); }
}

__device__ __forceinline__ void glaa_item(const bf16_t* P, const float* LR, const float* wgate, const float* bgate, float* BCUM, float* AEND, float* LCT, unsigned char* smem, int it, int tid) {
    const int bh = it >> 5, cn = it & 31, b = bh >> 2, h = bh & 3; const size_t m0 = (size_t)b * SEQ + cn * 64;
    const int lane = tid & 63, w = tid >> 6, c16 = lane & 15, q = lane >> 4;
    float* lrs = (float*)smem;
    float* part = (float*)(smem + 4096);
    bf16_t* KdT = (bf16_t*)(smem + 8192);
    bf16_t* VT = (bf16_t*)(smem + 8192 + 18432);
    if (tid < 256) *(f32x4*)(lrs + 4 * tid) = *(const f32x4*)(LR + m0 * 16 + 4 * tid);
    stage_vt64(P, m0, C_GLV + h * 256, VT, tid);
    __syncthreads();
    const int k = tid & 127, tg = tid >> 7;
    float wg[16];
#pragma unroll
    for (int r = 0; r < 16; ++r) wg[r] = wgate[r * 512 + h * 128 + k];
    const float bias = bgate[h * 128 + k];
    float bl[16]; float run = 0.f;
#pragma unroll
    for (int tt = 0; tt < 16; ++tt) { const float* lr = lrs + (16 * tg + tt) * 16; float z = bias;
#pragma unroll
        for (int r = 0; r < 16; ++r) z += lr[r] * wg[r];
        const float la = (fminf(z, 0.f) - __logf(1.f + __expf(-fabsf(z)))) * (1.f / 16.f);
        run += la; bl[tt] = run; }
    part[tg * 128 + k] = run;
    __syncthreads();
    float off = 0.f, bend = 0.f;
#pragma unroll
    for (int g2 = 0; g2 < 4; ++g2) { const float pv = part[g2 * 128 + k]; bend += pv; if (g2 < tg) off += pv; }
    if (tg == 0) AEND[(size_t)(bh * 32 + cn) * 128 + k] = __expf(bend);
    unsigned kd[8];
#pragma unroll
    for (int tt = 0; tt < 16; tt += 2) {
        const float b0 = bl[tt] + off, b1 = bl[tt + 1] + off; const size_t t0 = m0 + 16 * tg + tt;
        BCUM[t0 * 512 + h * 128 + k] = b0; BCUM[(t0 + 1) * 512 + h * 128 + k] = b1;
        const float k0v = bf2f(P[t0 * NPROJ + C_GLK + h * 128 + k]), k1v = bf2f(P[(t0 + 1) * NPROJ + C_GLK + h * 128 + k]);
        kd[tt >> 1] = pk2(k0v * __expf(bend - b0), k1v * __expf(bend - b1)); }
    { u32x4 w0, w1; w0.x = kd[0]; w0.y = kd[1]; w0.z = kd[2]; w0.w = kd[3]; w1.x = kd[4]; w1.y = kd[5]; w1.z = kd[6]; w1.w = kd[7];
      *(u32x4*)(KdT + k * 72 + 16 * tg) = w0; *(u32x4*)(KdT + k * 72 + 16 * tg + 8) = w1; }
    __syncthreads();
    float* out = LCT + (size_t)(bh * 32 + cn) * 32768;
#pragma unroll
    for (int vi = 0; vi < 2; ++vi) { const int vt = 2 * w + vi;
        const bf16x8 a0 = *(const bf16x8*)(VT + (16 * vt + c16) * 72 + 8 * q), a1 = *(const bf16x8*)(VT + (16 * vt + c16) * 72 + 32 + 8 * q);
#pragma unroll
        for (int kt = 0; kt < 8; ++kt) { f32x4 acc = {0.f, 0.f, 0.f, 0.f};
            const bf16x8 b0 = *(const bf16x8*)(KdT + (16 * kt + c16) * 72 + 8 * q), b1 = *(const bf16x8*)(KdT + (16 * kt + c16) * 72 + 32 + 8 * q);
            acc = MFMA16(a0, b0, acc); acc = MFMA16(a1, b1, acc);
#pragma unroll
            for (int j = 0; j < 4; ++j) out[(size_t)(16 * vt + 4 * q + j) * 128 + 16 * kt + c16] = acc[j]; } }
    __syncthreads();
}

__device__ __forceinline__ void glac_item(const bf16_t* P, const float* BCUM, const bf16_t* SNT, const float* gn, bf16_t* BR, unsigned char* smem, int it, int tid) {
    const int bh = it >> 5, cn = it & 31, b = bh >> 2, h = bh & 3; const size_t m0 = (size_t)b * SEQ + cn * 64;
    const int lane = tid & 63, w = tid >> 6, c16 = lane & 15, q = lane >> 4;
    bf16_t* Qd = (bf16_t*)smem;
    bf16_t* Ki = (bf16_t*)(smem + 17408);
    bf16_t* Pm = (bf16_t*)(smem + 34816);
    bf16_t* VT = (bf16_t*)(smem + 44032);
    float* st = (float*)(smem + 44032 + 36864);
    stage_vt64(P, m0, C_GLV + h * 256, VT, tid);
    { const int k = tid & 127, tg = tid >> 7;
#pragma unroll 4
      for (int tt = 0; tt < 16; ++tt) { const int t = 16 * tg + tt; const size_t m = m0 + t;
          const float bv = BCUM[m * 512 + h * 128 + k];
          const float qv = bf2f(P[m * NPROJ + C_GLQ + h * 128 + k]), kv = bf2f(P[m * NPROJ + C_GLK + h * 128 + k]);
          Qd[t * 136 + k] = (bf16_t)f2bf(qv * QSCALE * __expf(bv)); Ki[t * 136 + k] = (bf16_t)f2bf(kv * __expf(-bv)); } }
    __syncthreads();
#pragma unroll
    for (int ti = 0; ti < 2; ++ti) { const int tile = 2 * w + ti, tt = tile >> 2, stl = tile & 3; f32x4 acc = {0.f, 0.f, 0.f, 0.f};
        if (stl <= tt) {
#pragma unroll
            for (int ks = 0; ks < 4; ++ks) { const bf16x8 af = *(const bf16x8*)(Qd + (16 * tt + c16) * 136 + 32 * ks + 8 * q), bfr = *(const bf16x8*)(Ki + (16 * stl + c16) * 136 + 32 * ks + 8 * q);
                acc = MFMA16(af, bfr, acc); } }
#pragma unroll
        for (int j = 0; j < 4; ++j) { const int t = 16 * tt + 4 * q + j, s = 16 * stl + c16; Pm[t * 72 + s] = (bf16_t)f2bf((s <= t) ? acc[j] : 0.f); } }
    __syncthreads();
    {
        const int tt = w & 3, vt0 = 8 * (w >> 2);
        bf16x8 pa[2], qa[4];
#pragma unroll
        for (int ks = 0; ks < 2; ++ks) pa[ks] = *(const bf16x8*)(Pm + (16 * tt + c16) * 72 + 32 * ks + 8 * q);
#pragma unroll
        for (int ks = 0; ks < 4; ++ks) qa[ks] = *(const bf16x8*)(Qd + (16 * tt + c16) * 136 + 32 * ks + 8 * q);
        const bf16_t* Sg = SNT + (size_t)(bh * 32 + cn) * 32768;
        f32x4 o[8];
#pragma unroll
        for (int vi = 0; vi < 8; ++vi) { const int vt = vt0 + vi; f32x4 acc = {0.f, 0.f, 0.f, 0.f};
#pragma unroll
            for (int ks = 0; ks < 2; ++ks) { const bf16x8 bfr = *(const bf16x8*)(VT + (16 * vt + c16) * 72 + 32 * ks + 8 * q); acc = MFMA16(pa[ks], bfr, acc); }
#pragma unroll
            for (int ks = 0; ks < 4; ++ks) { const bf16x8 bfr = *(const bf16x8*)(Sg + (size_t)(16 * vt + c16) * 128 + 32 * ks + 8 * q); acc = MFMA16(qa[ks], bfr, acc); }
            o[vi] = acc; }
        float s1[4], s2[4];
#pragma unroll
        for (int j = 0; j < 4; ++j) { float a1 = 0.f, a2 = 0.f;
#pragma unroll
            for (int vi = 0; vi < 8; ++vi) { a1 += o[vi][j]; a2 += o[vi][j] * o[vi][j]; }
#pragma unroll
            for (int x = 1; x < 16; x <<= 1) { a1 += __shfl_xor(a1, x); a2 += __shfl_xor(a2, x); }
            s1[j] = a1; s2[j] = a2; }
        if (c16 == 0) {
#pragma unroll
            for (int j = 0; j < 4; ++j) { st[((w >> 2) * 64 + 16 * tt + 4 * q + j) * 2] = s1[j]; st[((w >> 2) * 64 + 16 * tt + 4 * q + j) * 2 + 1] = s2[j]; } }
        __syncthreads();
#pragma unroll
        for (int j = 0; j < 4; ++j) { const int t = 16 * tt + 4 * q + j;
            const float a1 = st[t * 2] + st[(64 + t) * 2], a2 = st[t * 2 + 1] + st[(64 + t) * 2 + 1];
            const float mean = a1 * (1.f / 256.f), var = a2 * (1.f / 256.f) - mean * mean, rstd = rsqrtf(var + 1e-5f);
            const size_t m = m0 + t;
#pragma unroll
            for (int vi = 0; vi < 8; ++vi) { const int v = 16 * (vt0 + vi) + c16;
                const float r = bf2f(P[m * NPROJ + C_GLR + h * 256 + v]);
                BR[m * NBR + BR_GLA + h * 256 + v] = (bf16_t)f2bf((o[vi][j] - mean) * rstd * gn[h * 256 + v] * siluf_(r)); } }
    }
    __syncthreads();
}

template <bool MASKED>
__device__ __forceinline__ void sb_weights(const f32x4 (&s)[4], int key0, int tq, int q, float& R, bf16x8& wA, bf16x8& wB) {
    constexpr float SC2 = QSCALE * 1.4426950408889634f;
    float z[4][4], c[4][4];
#pragma unroll
    for (int sb = 0; sb < 4; ++sb)
#pragma unroll
        for (int j = 0; j < 4; ++j) { z[sb][j] = s[sb][j] * SC2; const float sp = __builtin_amdgcn_logf(1.f + __builtin_amdgcn_exp2f(z[sb][j]));
            c[sb][j] = (!MASKED || (key0 + 16 * sb + 4 * q + j) < tq) ? sp : 0.f; }
    float aft[4], all[4];
#pragma unroll
    for (int sb = 0; sb < 4; ++sb) { c[sb][2] += c[sb][3]; c[sb][1] += c[sb][2]; c[sb][0] += c[sb][1];
        const float T = c[sb][0], ax = __shfl_xor(T, 16), bx = T + ax, cx = __shfl_xor(bx, 32);
        aft[sb] = ((q & 1) ? 0.f : ax) + ((q & 2) ? 0.f : cx); all[sb] = bx + cx; }
    float base[4];
    base[3] = R + aft[3]; base[2] = R + all[3] + aft[2]; base[1] = R + all[3] + all[2] + aft[1]; base[0] = R + all[3] + all[2] + all[1] + aft[0];
    R += (all[0] + all[1]) + (all[2] + all[3]);
    float wv[4][4];
#pragma unroll
    for (int sb = 0; sb < 4; ++sb)
#pragma unroll
        for (int j = 0; j < 4; ++j) { const float e = __builtin_amdgcn_exp2f(z[sb][j] - (c[sb][j] + base[sb]));
            wv[sb][j] = (!MASKED || (key0 + 16 * sb + 4 * q + j) < tq) ? e : 0.f; }
    union { bf16x8 v; unsigned u[4]; } a, b;
    a.u[0] = pk2(wv[0][0], wv[0][1]); a.u[1] = pk2(wv[0][2], wv[0][3]); a.u[2] = pk2(wv[1][0], wv[1][1]); a.u[3] = pk2(wv[1][2], wv[1][3]);
    b.u[0] = pk2(wv[2][0], wv[2][1]); b.u[1] = pk2(wv[2][2], wv[2][3]); b.u[2] = pk2(wv[3][0], wv[3][1]); b.u[3] = pk2(wv[3][2], wv[3][3]);
    wA = a.v; wB = b.v;
}

__device__ __forceinline__ void attn_unit(const bf16_t* P, bf16_t* BR, unsigned char* smem, int unit, int tid) {
    const int lane = tid & 63, w = tid >> 6, c16 = lane & 15, q = lane >> 4;
    bf16_t* KsB = (bf16_t*)smem;
    bf16_t* VTB = (bf16_t*)(smem + 34816);
    const int bh = unit >> 3, pr = unit & 7, b = bh >> 3, h = bh & 7;
    const int lkey = tid >> 4, ld8 = (tid & 15) * 8;
    const int keyA = lkey ^ (4 * (tid & 15)), keyB = keyA ^ 32;
    const bf16_t* Kg = P + (size_t)b * SEQ * NPROJ + C_SBK + h * 128 + ld8;
    const bf16_t* Vg = P + (size_t)b * SEQ * NPROJ + C_SBV + h * 128 + ld8;
    for (int half = 0; half < 2; ++half) {
        const int qb = half ? 15 - pr : pr;
        const int tq = qb * 128 + 16 * w + c16;
        const size_t mq = (size_t)b * SEQ + tq;
        bf16x8 qf[4];
#pragma unroll
        for (int ks = 0; ks < 4; ++ks) qf[ks] = *(const bf16x8*)(P + mq * NPROJ + C_SBQ + h * 128 + 32 * ks + 8 * q);
        f32x4 o[8];
#pragma unroll
        for (int d = 0; d < 8; ++d) o[d] = (f32x4){0.f, 0.f, 0.f, 0.f};
        float R = 0.f;
        const int nt = 2 * qb + 2;
        u32x4 pk0, pk1, pv0, pv1;
        { const size_t r0 = (size_t)((nt - 1) * 64 + lkey) * NPROJ, r1 = r0 + (size_t)32 * NPROJ;
          pk0 = *(const u32x4*)(Kg + r0); pk1 = *(const u32x4*)(Kg + r1); pv0 = *(const u32x4*)(Vg + r0); pv1 = *(const u32x4*)(Vg + r1); }
        for (int it = 0; it < nt; ++it) {
            const int kt = nt - 1 - it, key0 = kt * 64;
            bf16_t* Ks = KsB + (it & 1) * 8704; bf16_t* VT = VTB + (it & 1) * 9216;
            *(u32x4*)(Ks + lkey * 136 + ld8) = pk0; *(u32x4*)(Ks + (32 + lkey) * 136 + ld8) = pk1;
            { bf16_t* vd = VT + ld8 * 72 + keyA;
              vd[0 * 72] = (bf16_t)(pv0.x & 0xffffu); vd[1 * 72] = (bf16_t)(pv0.x >> 16); vd[2 * 72] = (bf16_t)(pv0.y & 0xffffu); vd[3 * 72] = (bf16_t)(pv0.y >> 16);
              vd[4 * 72] = (bf16_t)(pv0.z & 0xffffu); vd[5 * 72] = (bf16_t)(pv0.z >> 16); vd[6 * 72] = (bf16_t)(pv0.w & 0xffffu); vd[7 * 72] = (bf16_t)(pv0.w >> 16);
              vd = VT + ld8 * 72 + keyB;
              vd[0 * 72] = (bf16_t)(pv1.x & 0xffffu); vd[1 * 72] = (bf16_t)(pv1.x >> 16); vd[2 * 72] = (bf16_t)(pv1.y & 0xffffu); vd[3 * 72] = (bf16_t)(pv1.y >> 16);
              vd[4 * 72] = (bf16_t)(pv1.z & 0xffffu); vd[5 * 72] = (bf16_t)(pv1.z >> 16); vd[6 * 72] = (bf16_t)(pv1.w & 0xffffu); vd[7 * 72] = (bf16_t)(pv1.w >> 16); }
            __syncthreads();
            if (it + 1 < nt) { const size_t r0 = (size_t)((kt - 1) * 64 + lkey) * NPROJ, r1 = r0 + (size_t)32 * NPROJ;
                pk0 = *(const u32x4*)(Kg + r0); pk1 = *(const u32x4*)(Kg + r1); pv0 = *(const u32x4*)(Vg + r0); pv1 = *(const u32x4*)(Vg + r1); }
            const int tmin = qb * 128 + 16 * w;
            if (key0 <= tmin + 15) {
                f32x4 s[4];
#pragma unroll
                for (int sb = 0; sb < 4; ++sb) s[sb] = (f32x4){0.f, 0.f, 0.f, 0.f};
#pragma unroll
                for (int ks = 0; ks < 4; ++ks)
#pragma unroll
                    for (int sb = 0; sb < 4; ++sb) { const bf16x8 af = *(const bf16x8*)(Ks + (16 * sb + c16) * 136 + 32 * ks + 8 * q); s[sb] = MFMA16(af, qf[ks], s[sb]); }
                bf16x8 wA, wB;
                if (key0 + 64 <= tmin) sb_weights<false>(s, key0, tq, q, R, wA, wB);
                else sb_weights<true>(s, key0, tq, q, R, wA, wB);
#pragma unroll
                for (int dt = 0; dt < 8; ++dt) { const int m = (2 * dt + (c16 >> 3)) & 15; const bf16_t* vr = VT + (16 * dt + c16) * 72;
                    union { bf16x8 v; s16x4 hlf[2]; } aA, aB;
                    aA.hlf[0] = *(const s16x4*)(vr + 4 * (q ^ m)); aA.hlf[1] = *(const s16x4*)(vr + 4 * ((q + 4) ^ m));
                    aB.hlf[0] = *(const s16x4*)(vr + 4 * ((q + 8) ^ m)); aB.hlf[1] = *(const s16x4*)(vr + 4 * ((q + 12) ^ m));
                    o[dt] = MFMA16(aA.v, wA, o[dt]); o[dt] = MFMA16(aB.v, wB, o[dt]); }
            }
        }
#pragma unroll
        for (int dt = 0; dt < 8; ++dt) { u32x2 ov; ov.x = pk2(o[dt][0], o[dt][1]); ov.y = pk2(o[dt][2], o[dt][3]);
            *(u32x2*)(BR + mq * NBR + BR_SB + h * 128 + 16 * dt + 4 * q) = ov; }
    }
    __syncthreads();
}

#define XB_TMO      128
#define XB_XCNT(j)  (256  + 64 * (j))
#define XB_XSUB(j)  (1280 + 64 * (j))
#define XB_XGEN(j)  (2304 + 64 * (j))
#define XB_TOP      3328
#define XB_TOPGEN   3392
#define XCD_BAR_WORDS 3456
#define XB_SPIN_CAP (1u << 22)
__device__ __forceinline__ unsigned xb_ld(unsigned* p)              { return __hip_atomic_load(p, __ATOMIC_RELAXED, __HIP_MEMORY_SCOPE_AGENT); }
__device__ __forceinline__ unsigned xb_add(unsigned* p, unsigned v) { return __hip_atomic_fetch_add(p, v, __ATOMIC_RELAXED, __HIP_MEMORY_SCOPE_AGENT); }
__device__ __forceinline__ unsigned xb_xcc_id() { return (unsigned)__builtin_amdgcn_s_getreg((3 << 11) | 20) & 0xFu; }
#define XB_SPIN(cond, bar) do { unsigned _sp = 0; while (cond) { __builtin_amdgcn_s_sleep(1); \
    if ((++_sp & 255u) == 0u) { if (xb_ld(&(bar)[XB_TMO])) break; if (_sp > XB_SPIN_CAP) { atomicAdd(&(bar)[XB_TMO], 1u); break; } } } } while (0)
struct XcdBarrier { unsigned* bar; unsigned x; volatile LAS unsigned* st; };
__device__ __forceinline__ XcdBarrier xcd_barrier_post(unsigned* bar, volatile LAS unsigned* st) {
    XcdBarrier b; b.bar = bar; b.x = xb_xcc_id(); b.st = st;
    if (threadIdx.x == 0) (void)xb_add(&bar[XB_XCNT(b.x)], 1u);
    return b;
}
__device__ __forceinline__ void xcd_barrier_complete(unsigned* bar, unsigned x, unsigned& nloc, unsigned& nx) {
    const unsigned G = gridDim.x * gridDim.y * gridDim.z;
    unsigned sum, cnt, mine, sp = 0u;
    for (;;) {
        sum = 0u; cnt = 0u; mine = 0u;
#pragma unroll
        for (unsigned j = 0; j < 16; ++j) { const unsigned c = xb_ld(&bar[XB_XCNT(j)]); sum += c; cnt += (c > 0u) ? 1u : 0u; mine = (j == x) ? c : mine; }
        if (sum == G) break;
        __builtin_amdgcn_s_sleep(1);
        if ((++sp & 255u) == 0u) { if (xb_ld(&bar[XB_TMO])) break; if (sp > XB_SPIN_CAP) { atomicAdd(&bar[XB_TMO], 1u); break; } }
    }
    nloc = mine > 0u ? mine : 1u; nx = cnt > 0u ? cnt : 1u;
}
__device__ __forceinline__ void xcd_barrier(const XcdBarrier& b) {
    asm volatile("s_waitcnt vmcnt(0)" ::: "memory");
    __syncthreads();
    if (threadIdx.x == 0) {
        unsigned* bar = b.bar;
        __builtin_amdgcn_s_waitcnt(0);
        unsigned nloc = b.st[0], nx = b.st[1];
        if (nloc == 0u) { xcd_barrier_complete(bar, b.x, nloc, nx); b.st[0] = nloc; b.st[1] = nx; }
        const unsigned old = xb_add(&bar[XB_XSUB(b.x)], 1u);
        const unsigned gen = old / nloc;
        if (old + 1u == (gen + 1u) * nloc) {
            __builtin_amdgcn_fence(__ATOMIC_RELEASE, "agent");
            asm volatile("s_waitcnt vmcnt(0)" ::: "memory");
            const unsigned og = xb_add(&bar[XB_TOP], 1u);
            const unsigned tg = og / nx;
            if (og + 1u == (tg + 1u) * nx) xb_add(&bar[XB_TOPGEN], 1u);
            else XB_SPIN(xb_ld(&bar[XB_TOPGEN]) == tg, bar);
            __builtin_amdgcn_fence(__ATOMIC_ACQUIRE, "agent");
            xb_add(&bar[XB_XGEN(b.x)], 1u);
            asm volatile("s_waitcnt vmcnt(0)" ::: "memory");
        } else {
            XB_SPIN(xb_ld(&bar[XB_XGEN(b.x)]) == gen, bar);
            __builtin_amdgcn_fence(__ATOMIC_ACQUIRE, "agent");
            asm volatile("s_waitcnt vmcnt(0)" ::: "memory");
        }
    }
    __syncthreads();
}

constexpr int NPH = 23;
__global__ void __launch_bounds__(512, 2) mk_fwd(Args a) {
    extern __shared__ __attribute__((aligned(16))) unsigned char smem[];
    cg::grid_group grid = cg::this_grid();
    int tid = threadIdx.x, lane = tid & 63, wave = __builtin_amdgcn_readfirstlane(tid >> 6);
    int G = gridDim.x, bid = blockIdx.x, gw = bid * 8 + wave, ngw = G * 8;
    LAS unsigned char* lds = (LAS unsigned char*)smem;
    unsigned char* ws = a.ws;
    float* MOD = (float*)(ws + WS_MOD);
    bf16_t* H = (bf16_t*)(ws + WS_H); bf16_t* PROJ = (bf16_t*)(ws + WS_PROJ); bf16_t* ACT = (bf16_t*)(ws + WS_ACT);
    bf16_t* BR = (bf16_t*)(ws + WS_BR); float* Y = (float*)(ws + WS_Y); bf16_t* MBF = (bf16_t*)(ws + WS_MB); float* X1 = (float*)(ws + WS_X1);
    float* SLOC = (float*)(ws + WS_SLOC); bf16_t* SPREV = (bf16_t*)(ws + WS_SPREV); float* BCUM = (float*)(ws + WS_BCUM);
    float* AEND = (float*)(ws + WS_AEND); float* LRB = (float*)(ws + WS_LR); float* LCT = (float*)(ws + WS_LCT); bf16_t* SNT = (bf16_t*)(ws + WS_SNT);
    const int lo = a.ph_lo, hi = a.ph_hi;
    volatile LAS unsigned* xst = (volatile LAS unsigned*)(lds + LDS_BYTES - 64);
    if (tid == 0) { xst[0] = 0u; xst[1] = 0u; }
    __syncthreads();
    XcdBarrier xbar = xcd_barrier_post((unsigned*)(ws + WS_CTL), xst);
#define IN(k) (lo <= (k) && (k) < hi)
#ifndef DUP_BR
#define DUP_BR 0
#endif
#ifndef DUP_PROJ
#define DUP_PROJ 0
#endif
#ifndef DUP_GU
#define DUP_GU 0
#endif
#ifndef DUP_WO
#define DUP_WO 0
#endif
#ifndef DUP_DOWN
#define DUP_DOWN 0
#endif
#ifndef REPMASK
#define REPMASK 0u
#endif
#define REPS(kind) ((((unsigned)(REPMASK) >> (kind)) & 1u) ? 2 : 1)
#define PHASE(k, kind) if (IN(k)) for (int rep_ = 0; rep_ < REPS(kind); ++rep_, (rep_ < REPS(kind) ? (xcd_barrier(xbar), 0) : 0))
#define SEAM(k) do { if (IN(k) && IN((k) + 1)) { if ((k) == 0) grid.sync(); else xcd_barrier(xbar); } FRESH(); } while (0)
#define FRESH() do { tid = threadIdx.x; asm volatile("" : "+v"(tid)); lane = tid & 63; wave = __builtin_amdgcn_readfirstlane(tid >> 6); bid = blockIdx.x; asm volatile("" : "+s"(bid)); G = gridDim.x; asm volatile("" : "+s"(G)); gw = bid * 8 + wave; ngw = G * 8; } while (0)

    PHASE(0, 0) {
        {
            float* sc = (float*)smem;
            for (int i = tid; i < NB * DM; i += 512) sc[i] = siluf_(a.in[I_C][i]);
            __syncthreads();
            for (int it = bid; it < 384; it += G) p0_adaln_item(a, smem, it, tid);
            __syncthreads();
        }
        for (int it = bid; it < 128; it += G) p0_s5pre_item(a, smem, it, tid);
        __syncthreads();
        p0_transposes(a, smem, gw, ngw, wave, lane);
        __syncthreads();
    }
    SEAM(0);

    for (int l = 0; l < 2; ++l) {
        const int pb = 1 + 11 * l;
        const unsigned char* wl = ws + WS_W + (size_t)l * W_LAYER;
        const unsigned char* s5w = ws + WS_S5M + (size_t)l * S5_LAYER;
        const float* modl = MOD + (size_t)l * 4 * 12288;
        const float* xin = l == 0 ? a.in[I_X] : a.out;
        PHASE(pb + 0, 1) if (l == 0) ln_phase(xin, nullptr, nullptr, nullptr, modl + 2048, modl, H, gw, ngw, lane);
        if (l == 0) SEAM(pb + 0);
        PHASE(pb + 1, 2) { pg8::Gemm g{H, (const bf16_t*)(wl + WO_WIN), DM, DM, DM}; pg8::StaticOrder S; S.init(MTOK, NPROJ, G, bid); S.dup = DUP_PROJ;
            pg8::EpiBf16 E{PROJ, NPROJ}; pg8::gemm_phase(lds, g, S, E, tid);
            if (wave < 2 && bid + G * wave < 512) lr_item(H, (const bf16_t*)(wl + WO_WIN) + (size_t)18432 * DM, LRB, bid + G * wave, lane); }
        SEAM(pb + 1);
        PHASE(pb + 2, 3) {
#ifndef REP_ATTN
#define REP_ATTN 1
#endif
#ifndef REP_GLAA
#define REP_GLAA 1
#endif
            for (int rr = 0; rr < REP_ATTN; ++rr) for (int u = bid; u < 256; u += G) attn_unit(PROJ, BR, smem, u, tid);
            for (int rr = 0; rr < REP_GLAA; ++rr) for (int it = bid; it < 512; it += G) glaa_item(PROJ, LRB, a.in[I_GLAWG] + (size_t)l * 16 * 512, a.in[I_GLABG] + l * 512, BCUM, AEND, LCT, smem, it, tid);
            for (int it = gw; it < 2048; it += ngw) s5a_item(PROJ, (const bf16_t*)(s5w + S5O_MIN), SLOC, it, lane);
            for (int it = bid; it < 2048; it += G) conv_item(PROJ, BR, a.in[I_CONVW] + (size_t)l * 3 * 1024, it, tid);
        }
        SEAM(pb + 2);
        PHASE(pb + 3, 4) {
            for (int it = bid; it < 32 + 1024; it += G) {
                if (it < 32) { const int idx = it * 512 + tid, b = idx >> 12, g = (idx >> 6) & 63, p = idx & 63;
                    const float2 ab = ((const float2*)(s5w + S5O_A16))[g * 64 + p]; float sr = 0.f, si = 0.f;
#pragma unroll 4
                    for (int c = 0; c < 128; ++c) { const size_t base = ((size_t)(b * 128 + c) * 64 + g) * 128;
                        SPREV[base + p] = (bf16_t)f2bf(sr); SPREV[base + 64 + p] = (bf16_t)f2bf(si);
                        const float lr = SLOC[base + p], li = SLOC[base + 64 + p];
                        const float nr = ab.x * sr - ab.y * si + lr, ni = ab.x * si + ab.y * sr + li; sr = nr; si = ni; } }
                else { const int idx = (it - 32) * 512 + tid, bh = idx >> 15, e = idx & 32767, k = e & 127; float s = 0.f;
#pragma unroll 4
                    for (int cn = 0; cn < 32; ++cn) { const size_t base = (size_t)(bh * 32 + cn);
                        SNT[base * 32768 + e] = (bf16_t)f2bf(s);
                        s = AEND[base * 128 + k] * s + LCT[base * 32768 + e]; } }
            }
        }
        SEAM(pb + 3);
        PHASE(pb + 4, 5) {
            for (int it = bid; it < 512; it += G) glac_item(PROJ, BCUM, SNT, a.in[I_GLANG] + l * 1024, BR, smem, it, tid);
            for (int it = gw; it < 2048; it += ngw) s5c_item(PROJ, (const bf16_t*)(s5w + S5O_MROW), SPREV, a.in[I_S5D] + l * 1024, BR, it, lane);
        }
        SEAM(pb + 4);
        PHASE(pb + 5, 6) { pg8::Gemm g{BR, (const bf16_t*)(wl + WO_WBR), NBR, 1024, 1024}; pg8::BranchOrder S{G, bid, DUP_BR};
            pg8::EpiBranch E{PROJ, Y, MBF}; pg8::gemm_phase(lds, g, S, E, tid); }
        SEAM(pb + 5);
        PHASE(pb + 6, 7) { pg8::Gemm g{MBF, (const bf16_t*)(wl + WO_WO), DM, DM, DM}; pg8::StaticOrder S; S.init(MTOK, DM, G, bid); S.dup = DUP_WO;
            pg8::EpiResid E{xin, modl + 2 * 2048, Y}; pg8::gemm_phase(lds, g, S, E, tid); }
        SEAM(pb + 6);
        PHASE(pb + 7, 8) ln_phase(Y, a.in[I_LN1G] + l * DM, a.in[I_LN1B] + l * DM, X1, modl + 4 * 2048, modl + 3 * 2048, H, gw, ngw, lane);
        SEAM(pb + 7);
        PHASE(pb + 8, 9) { pg8::Gemm g{H, (const bf16_t*)(wl + WO_WGU), DM, DM, DM}; pg8::StaticOrder S; S.init(MTOK, NGU, G, bid); S.dup = DUP_GU;
            pg8::EpiGateUp E{ACT}; pg8::gemm_phase(lds, g, S, E, tid); }
        SEAM(pb + 8);
        PHASE(pb + 9, 10) { pg8::Gemm g{ACT, (const bf16_t*)(wl + WO_WD), DFF, DFF, DFF}; pg8::StaticOrder S; S.init(MTOK, DM, G, bid); S.dup = DUP_DOWN;
            pg8::EpiResid E{X1, modl + 5 * 2048, Y}; pg8::gemm_phase(lds, g, S, E, tid); }
        SEAM(pb + 9);
        PHASE(pb + 10, 11) { const float* modn = MOD + (size_t)(l + 1) * 4 * 12288;
            ln_phase(Y, a.in[I_LN2G] + l * DM, a.in[I_LN2B] + l * DM, a.out, l == 0 ? modn + 2048 : nullptr, l == 0 ? modn : nullptr, H, gw, ngw, lane); }
        if (l == 0) SEAM(pb + 10);
    }
#undef IN
#undef SEAM
}

#ifndef MK_SPLIT
#define MK_SPLIT 0
#endif
extern "C" void kernel_launch(void* const* d_in, const int* in_sizes, int n_in, void* d_out, int out_size, void* d_ws, size_t ws_size, hipStream_t stream) {
    static int grid = 0;
    if (grid == 0) {
        if (n_in != 30 || ws_size < WS_END) { fprintf(stderr, "kernel_launch: unexpected n_in %d or ws_size %zu (< %zu)\n", n_in, ws_size, (size_t)WS_END); grid = -1; return; }
        int dev = 0, cus = 0, per_cu = 0;
        hipGetDevice(&dev); hipDeviceGetAttribute(&cus, hipDeviceAttributeMultiprocessorCount, dev);
        if (hipFuncSetAttribute((const void*)mk_fwd, hipFuncAttributeMaxDynamicSharedMemorySize, LDS_BYTES) != hipSuccess) { fprintf(stderr, "kernel_launch: hipFuncSetAttribute failed\n"); grid = -1; return; }
        if (hipOccupancyMaxActiveBlocksPerMultiprocessor(&per_cu, (const void*)mk_fwd, 512, LDS_BYTES) != hipSuccess || per_cu < 1) { fprintf(stderr, "kernel_launch: occupancy query says %d\n", per_cu); per_cu = 1; }
        (void)hipGetLastError();
        grid = cus > 256 ? 256 : cus;
    }
    if (grid < 0) return;
    if (hipMemsetAsync((char*)d_ws + WS_CTL, 0, CTL_BYTES, stream) != hipSuccess) { fprintf(stderr, "memset failed\n"); return; }
    Args a{};
    for (int i = 0; i < 30; ++i) a.in[i] = (const float*)d_in[i];
    a.out = (float*)d_out; a.ws = (unsigned char*)d_ws;
#if MK_SPLIT
    for (int ph = 0; ph < NPH; ++ph) { a.ph_lo = ph; a.ph_hi = ph + 1; hipLaunchKernelGGL(mk_fwd, dim3(grid), dim3(512), LDS_BYTES, stream, a); }
#else
    a.ph_lo = 0; a.ph_hi = NPH;
    void* args[] = {&a};
    hipError_t e = hipLaunchCooperativeKernel((const void*)mk_fwd, dim3(grid), dim3(512), args, LDS_BYTES, stream);
    if (e != hipSuccess) fprintf(stderr, "cooperative launch failed: %s (grid %d)\n", hipGetErrorString(e), grid);
#endif
}
```

```cpp
#include <hip/hip_runtime.h>
#include <hip/hip_cooperative_groups.h>
#include <cstdio>
#include <cstdint>
namespace cg = cooperative_groups;

#define LAS __attribute__((address_space(3)))
typedef unsigned short bf16_t;
typedef short bf16x8 __attribute__((ext_vector_type(8)));
typedef short s16x4 __attribute__((ext_vector_type(4)));
typedef float f32x4 __attribute__((ext_vector_type(4)));
typedef unsigned u32x4 __attribute__((ext_vector_type(4)));
typedef unsigned u32x2 __attribute__((ext_vector_type(2)));

constexpr int DM = 2048, NB = 4, SEQ = 2048, MTOK = NB * SEQ, NPROJ = 18432, NIN = 18448, DFF = 5632, NGU = 2 * DFF;
constexpr int C_CVB = 0, C_CVC = 1024, C_CVX = 2048, C_S5U = 3072, C_SBQ = 4096, C_SBK = 5120, C_SBV = 6144, C_GLQ = 7168,
              C_GLK = 7680, C_GLV = 8192, C_GLR = 9216, C_GCONV = 10240, C_GS5 = 12288, C_GSB = 14336, C_GGLA = 16384;
constexpr int BR_CONV = 0, BR_S5 = 1024, BR_SB = 2048, BR_GLA = 3072, NBR = 4096;
constexpr float ALPHA = 1.41421356237f;
constexpr float QSCALE = 0.08838834764831845f;

constexpr size_t MiB = 1u << 20;
constexpr size_t W_LAYER = 167 * MiB;
constexpr size_t WO_WIN = 0, WO_WBR = 73 * MiB, WO_WO = 93 * MiB, WO_WGU = 101 * MiB, WO_WD = 145 * MiB;
constexpr size_t WS_W = 0;
constexpr size_t WS_S5M = 334 * MiB;
constexpr size_t S5_LAYER = 17 * MiB, S5O_MROW = 0, S5O_MIN = 12 * MiB, S5O_A16 = 16 * MiB;
constexpr size_t WS_MOD = 368 * MiB;
constexpr size_t WS_H = 369 * MiB;
constexpr size_t WS_PROJ = 401 * MiB;
constexpr size_t WS_ACT = WS_PROJ;
constexpr size_t WS_BR = 693 * MiB;
constexpr size_t WS_Y = 757 * MiB;
constexpr size_t WS_MB = 821 * MiB;
constexpr size_t WS_X1 = 853 * MiB;
constexpr size_t WS_SLOC = 917 * MiB;
constexpr size_t WS_SPREV = 933 * MiB;
constexpr size_t WS_BCUM = 941 * MiB;
constexpr size_t WS_AEND = 957 * MiB;
constexpr size_t WS_LR = WS_AEND + 512 * 1024;
constexpr size_t WS_LCT = 958 * MiB;
constexpr size_t WS_SNT = 1022 * MiB;
constexpr size_t WS_CTL = 1054 * MiB;
constexpr size_t CTL_BYTES = 16384;
constexpr size_t WS_END = 1055 * MiB;

constexpr int LDS_BYTES = 147456;

__device__ __forceinline__ float bf2f(unsigned u) { return __builtin_bit_cast(float, u << 16); }
__device__ __forceinline__ unsigned f2bf(float f) { unsigned u = __builtin_bit_cast(unsigned, f); return (u + 0x7fffu + ((u >> 16) & 1u)) >> 16; }
__device__ __forceinline__ unsigned pk2(float lo, float hi) { return f2bf(lo) | (f2bf(hi) << 16); }
__device__ __forceinline__ float lo16(unsigned w) { return __builtin_bit_cast(float, w << 16); }
__device__ __forceinline__ float hi16(unsigned w) { return __builtin_bit_cast(float, w & 0xffff0000u); }
__device__ __forceinline__ float sigm(float x) { return 1.f / (1.f + __expf(-x)); }
__device__ __forceinline__ float siluf_(float x) { return x / (1.f + __expf(-x)); }
__device__ __forceinline__ float gelu_tanh(float x) { float u = 0.7978845608028654f * (x + 0.044715f * x * x * x); float t = 1.f - 2.f / (1.f + __expf(2.f * u)); return 0.5f * x * (1.f + t); }
__device__ __forceinline__ float softplusf_(float z) { return fmaxf(z, 0.f) + __logf(1.f + __expf(-fabsf(z))); }
__device__ __forceinline__ float wave_sum(float v) {
#pragma unroll
    for (int o = 1; o < 64; o <<= 1) v += __shfl_xor(v, o);
    return v;
}
#define MFMA16(a, b, c) __builtin_amdgcn_mfma_f32_16x16x32_bf16((a), (b), (c), 0, 0, 0)

namespace pg8 {
constexpr int BM = 256, BK = 64, HALF = 128, HTB = HALF * BK * 2, NXCD = 8, WGM = 8;
__host__ __device__ __forceinline__ int lds_byte(int r, int c) { const int st = (r >> 4) * 2 + (c >> 5), rr = r & 15, cc = c & 31, ob = rr * 64 + cc * 2; return st * 1024 + (ob ^ (((ob >> 9) & 1) << 5)); }
__host__ __device__ __forceinline__ void stage_rc(int b, int& R, int& C) { const int st = b / 1024, sb = b % 1024, swz = sb ^ (((sb >> 9) & 1) << 5); R = (st >> 1) * 16 + swz / 64; C = (st & 1) * 32 + (swz % 64) / 2; }
__host__ __device__ __forceinline__ int perm32(int rho) { const int n = rho >> 4, i = rho & 15; return 8 * (i >> 2) + 4 * n + (i & 3); }

struct Unit { int pm, pn, acol, mode; };
struct Gemm { const bf16_t* A; const bf16_t* Bt; int lda, ldb, K; };

struct StaticOrder {
    int nM, nN, nwg, G, c, dup = 0;
    __device__ void init(int M, int N, int G_, int c_) { nM = M / BM; nN = N / BM; nwg = nM * nN; G = G_; c = c_; }
    __device__ bool next(int i, Unit& u) const {
        const long L = (long)(i >> dup) * G + c; if (L >= nwg) return false;
        int wgid = (int)L; { const int q = nwg / NXCD, r = nwg % NXCD, xcd = wgid % NXCD, off = wgid / NXCD; wgid = (xcd < r ? xcd * (q + 1) : r * (q + 1) + (xcd - r) * q) + off; }
        const int nig = WGM * nN, gid = wgid / nig, fm = gid * WGM, gsz = (nM - fm) < WGM ? (nM - fm) : WGM;
        u.pm = fm + ((wgid % nig) % gsz); u.pn = (wgid % nig) / gsz; u.acol = 0; u.mode = 0; return true;
    }
};
struct BranchOrder {
    int G, c, dup = 0;
    __device__ bool next(int i, Unit& u) const {
        const int L = ((i / 5) >> dup) * G + c; if (L >= 256) return false;
        const int sub = i % 5, pn8 = L & 7; u.pm = L >> 3;
        if (sub == 0) { u.pn = pn8; u.acol = BR_CONV; u.mode = 0; }
        else if (sub == 1) { u.pn = 8 + pn8; u.acol = BR_SB; u.mode = 1; }
        else if (sub == 2) { u.pn = 16 + pn8; u.acol = BR_GLA; u.mode = 2; }
        else { u.pn = 24 + 2 * pn8 + (sub - 3); u.acol = BR_S5; u.mode = 3; }
        return true;
    }
};

template <class Epi, class Sched>
__device__ __forceinline__ void gemm_phase(LAS unsigned char* lds, const Gemm g, const Sched& S, const Epi& E, int tid) {
    const int wid = __builtin_amdgcn_readfirstlane(tid >> 6), lane = tid & 63, wr = wid >> 2, wc = wid & 3, fr = lane & 15, fq = lane >> 4;
    const int K = g.K, nt = K / BK;
    unsigned voffA[2], voffB[2];
#pragma unroll
    for (int i = 0; i < 2; ++i) { int R, C; stage_rc(tid * 16 + i * 8192, R, C); const int Rb = (R & ~31) + perm32(R & 31);
        voffA[i] = (unsigned)(R * g.lda + C) * 2u; voffB[i] = (unsigned)(Rb * g.ldb + C) * 2u; }
    const size_t kstep = (size_t)(BK * 2);
    const size_t hstepA = (size_t)HALF * g.lda * 2, hstepB = (size_t)HALF * g.ldb * 2;
    const size_t tstepA = 2 * hstepA, tstepB = 2 * hstepB;
    const unsigned ldsw = (unsigned)wid * 1024u;
    const int aoff = lds_byte(wr * 64 + fr, fq * 8), boff = lds_byte(wc * 32 + fr, fq * 8);
#define PG8_SA(b, h) (((b) * 2 + (h)) * HTB)
#define PG8_SB(b, h) ((4 + (b) * 2 + (h)) * HTB)
#define PG8_STAGE(bufoff, gbase, voff) do { _Pragma("unroll") for (int _i = 0; _i < 2; ++_i) \
        __builtin_amdgcn_global_load_lds((const unsigned*)((const char*)(gbase) + (voff)[_i]), (LAS unsigned*)(lds + (bufoff) + ldsw + _i * 8192), 16, 0, 0); } while (0)
#define PG8_LDA(dst, b, h) do { _Pragma("unroll") for (int m = 0; m < 4; ++m) _Pragma("unroll") for (int k = 0; k < 2; ++k) dst[m][k] = *(const LAS bf16x8*)(lds + PG8_SA(b, h) + aoff + m * 2048 + k * 1024); } while (0)
#define PG8_LDB(dst, b, h) do { _Pragma("unroll") for (int n = 0; n < 2; ++n) _Pragma("unroll") for (int k = 0; k < 2; ++k) dst[n][k] = *(const LAS bf16x8*)(lds + PG8_SB(b, h) + boff + n * 2048 + k * 1024); } while (0)
#define PG8_MMA(ai, bj, At, Bt) do { __builtin_amdgcn_s_setprio(1); _Pragma("unroll") for (int m = 0; m < 4; ++m) _Pragma("unroll") for (int n = 0; n < 2; ++n) _Pragma("unroll") for (int k = 0; k < 2; ++k) \
        acc[ai][bj][m][n] = __builtin_amdgcn_mfma_f32_16x16x32_bf16(Bt[n][k], At[m][k], acc[ai][bj][m][n], 0, 0, 0); __builtin_amdgcn_s_setprio(0); } while (0)
#define PG8_WAIT_V(n) asm volatile("s_waitcnt vmcnt(" #n ")" ::: "memory")
#define PG8_WAIT_L(n) asm volatile("s_waitcnt lgkmcnt(" #n ")" ::: "memory")
#define PG8_BAR __builtin_amdgcn_s_barrier()
#define PG8_SCHED __builtin_amdgcn_sched_barrier(0)
    Unit cur, nxt; int ui = 0;
    if (!S.next(0, cur)) return;
    f32x4 acc[2][2][4][2];
#pragma unroll
    for (int a = 0; a < 2; ++a)
#pragma unroll
        for (int b = 0; b < 2; ++b)
#pragma unroll
            for (int m = 0; m < 4; ++m)
#pragma unroll
                for (int n = 0; n < 2; ++n) acc[a][b][m][n] = (f32x4){0.f, 0.f, 0.f, 0.f};
    bf16x8 At[4][2], B0[2][2], B1[2][2];
    const char* cA = (const char*)g.A + (size_t)cur.pm * tstepA + (size_t)cur.acol * 2; const char* cB = (const char*)g.Bt + (size_t)cur.pn * tstepB;
    PG8_STAGE(PG8_SB(0, 0), cB, voffB); PG8_STAGE(PG8_SB(0, 1), cB + hstepB, voffB); PG8_STAGE(PG8_SA(0, 0), cA, voffA); PG8_STAGE(PG8_SA(0, 1), cA + hstepA, voffA);
    if (wr == 1) PG8_BAR;
    PG8_WAIT_V(2); PG8_BAR;
    PG8_STAGE(PG8_SB(1, 0), cB + kstep, voffB); PG8_STAGE(PG8_SA(1, 0), cA + kstep, voffA); PG8_STAGE(PG8_SB(1, 1), cB + hstepB + kstep, voffB);
    PG8_WAIT_V(6); PG8_BAR;
    for (;;) {
        const bool has_next = S.next(ui + 1, nxt);
        const char* nA = has_next ? (const char*)g.A + (size_t)nxt.pm * tstepA + (size_t)nxt.acol * 2 : cA; const char* nB = has_next ? (const char*)g.Bt + (size_t)nxt.pn * tstepB : cB;
        for (int t = 0; t < nt; t += 2) {
            const bool last = (t == nt - 2);
            const char* a1 = cA + (size_t)(t + 1) * kstep;
            const char* a2 = last ? nA : cA + (size_t)(t + 2) * kstep; const char* b2 = last ? nB : cB + (size_t)(t + 2) * kstep;
            const char* a3 = a2 + kstep; const char* b3 = b2 + kstep;
            PG8_LDB(B0, 0, 0); PG8_LDB(B1, 0, 1); PG8_SCHED; PG8_LDA(At, 0, 0); PG8_STAGE(PG8_SA(1, 1), a1 + hstepA, voffA);
            PG8_WAIT_V(8); PG8_WAIT_L(0); PG8_BAR; PG8_MMA(0, 0, At, B0); PG8_MMA(0, 1, At, B1); PG8_BAR; PG8_SCHED;
            PG8_LDA(At, 0, 1); PG8_STAGE(PG8_SB(0, 0), b2, voffB); PG8_STAGE(PG8_SB(0, 1), b2 + hstepB, voffB); PG8_STAGE(PG8_SA(0, 0), a2, voffA);
            PG8_WAIT_V(8); PG8_WAIT_L(0); PG8_BAR; PG8_MMA(1, 0, At, B0); PG8_MMA(1, 1, At, B1); PG8_BAR; PG8_SCHED;
            PG8_LDB(B0, 1, 0); PG8_LDB(B1, 1, 1); PG8_SCHED; PG8_LDA(At, 1, 0); PG8_STAGE(PG8_SA(0, 1), a2 + hstepA, voffA);
            PG8_WAIT_V(8); PG8_WAIT_L(0); PG8_BAR; PG8_MMA(0, 0, At, B0); PG8_MMA(0, 1, At, B1); PG8_BAR; PG8_SCHED;
            PG8_LDA(At, 1, 1); PG8_STAGE(PG8_SB(1, 0), b3, voffB); PG8_STAGE(PG8_SB(1, 1), b3 + hstepB, voffB); PG8_STAGE(PG8_SA(1, 0), a3, voffA);
            PG8_WAIT_V(8); PG8_WAIT_L(0); PG8_BAR; PG8_MMA(1, 0, At, B0); PG8_MMA(1, 1, At, B1); PG8_BAR; PG8_SCHED;
        }
        E(acc, cur, wr, wc, fr, fq);
        if (!has_next) break;
#pragma unroll
        for (int a = 0; a < 2; ++a)
#pragma unroll
            for (int b = 0; b < 2; ++b)
#pragma unroll
                for (int m = 0; m < 4; ++m)
#pragma unroll
                    for (int n = 0; n < 2; ++n) acc[a][b][m][n] = (f32x4){0.f, 0.f, 0.f, 0.f};
        cur = nxt; cA = nA; cB = nB; ++ui;
    }
    PG8_WAIT_V(0);
    if (wr == 0) PG8_BAR;
    PG8_BAR;
#undef PG8_SA
#undef PG8_SB
#undef PG8_STAGE
#undef PG8_LDA
#undef PG8_LDB
#undef PG8_MMA
#undef PG8_WAIT_V
#undef PG8_WAIT_L
#undef PG8_BAR
#undef PG8_SCHED
}

struct EpiBf16 {
    bf16_t* O; int ldc;
    __device__ __forceinline__ void operator()(const f32x4 (&acc)[2][2][4][2], const Unit& u, int wr, int wc, int fr, int fq) const {
        const int row0 = u.pm * BM + wr * 64 + fr, col0 = u.pn * BM + wc * 32 + 8 * fq;
#pragma unroll
        for (int ai = 0; ai < 2; ++ai)
#pragma unroll
            for (int m = 0; m < 4; ++m) { bf16_t* rowp = O + (size_t)(row0 + ai * HALF + m * 16) * ldc + col0;
#pragma unroll
                for (int bj = 0; bj < 2; ++bj) { const f32x4 v0 = acc[ai][bj][m][0], v1 = acc[ai][bj][m][1];
                    u32x4 w; w.x = pk2(v0[0], v0[1]); w.y = pk2(v0[2], v0[3]); w.z = pk2(v1[0], v1[1]); w.w = pk2(v1[2], v1[3]);
                    *(u32x4*)(rowp + bj * HALF) = w; } }
    }
};
struct EpiGateUp {
    bf16_t* O;
    __device__ __forceinline__ void operator()(const f32x4 (&acc)[2][2][4][2], const Unit& u, int wr, int wc, int fr, int fq) const {
        const int row0 = u.pm * BM + wr * 64 + fr, col0 = u.pn * HALF + wc * 32 + 8 * fq;
#pragma unroll
        for (int ai = 0; ai < 2; ++ai)
#pragma unroll
            for (int m = 0; m < 4; ++m) { bf16_t* rowp = O + (size_t)(row0 + ai * HALF + m * 16) * DFF + col0;
                float r[8];
#pragma unroll
                for (int n = 0; n < 2; ++n)
#pragma unroll
                    for (int i = 0; i < 4; ++i) r[n * 4 + i] = siluf_(acc[ai][0][m][n][i]) * acc[ai][1][m][n][i];
                u32x4 w; w.x = pk2(r[0], r[1]); w.y = pk2(r[2], r[3]); w.z = pk2(r[4], r[5]); w.w = pk2(r[6], r[7]);
                *(u32x4*)rowp = w; }
    }
};
struct EpiResid {
    const float* X; const float* gate; float* Y;
    __device__ __forceinline__ void operator()(const f32x4 (&acc)[2][2][4][2], const Unit& u, int wr, int wc, int fr, int fq) const {
        const int row0 = u.pm * BM + wr * 64 + fr, col0 = u.pn * BM + wc * 32 + 8 * fq;
        const float* gp = gate + (size_t)(u.pm >> 3) * 12288 + col0;
#pragma unroll
        for (int bj = 0; bj < 2; ++bj) {
            const f32x4 g0 = *(const f32x4*)(gp + bj * HALF), g1 = *(const f32x4*)(gp + bj * HALF + 4);
#pragma unroll
            for (int ai = 0; ai < 2; ++ai) {
                f32x4 x0[4], x1[4];
#pragma unroll
                for (int m = 0; m < 4; ++m) { const size_t off = (size_t)(row0 + ai * HALF + m * 16) * DM + col0 + bj * HALF;
                    x0[m] = *(const f32x4*)(X + off); x1[m] = *(const f32x4*)(X + off + 4); }
#pragma unroll
                for (int m = 0; m < 4; ++m) { const size_t off = (size_t)(row0 + ai * HALF + m * 16) * DM + col0 + bj * HALF;
                    *(f32x4*)(Y + off) = x0[m] * ALPHA + g0 * acc[ai][bj][m][0];
                    *(f32x4*)(Y + off + 4) = x1[m] * ALPHA + g1 * acc[ai][bj][m][1]; }
            }
        }
    }
};
struct EpiBranch {
    const bf16_t* P; float* MG; bf16_t* MBF;
    __device__ __forceinline__ void operator()(const f32x4 (&acc)[2][2][4][2], const Unit& u, int wr, int wc, int fr, int fq) const {
        const int row0 = u.pm * BM + wr * 64 + fr;
        if (u.mode < 3) {
            const int col0 = u.pn * BM - u.mode * 2048 + wc * 32 + 8 * fq;
            const int gcol = (u.mode == 0 ? C_GCONV : (u.mode == 1 ? C_GSB : C_GGLA));
            const bool rmw = u.mode != 0;
#pragma unroll
            for (int ai = 0; ai < 2; ++ai)
#pragma unroll
                for (int mh = 0; mh < 2; ++mh) {
                    u32x4 gw[2][2]; f32x4 m0[2][2], m1[2][2];
#pragma unroll
                    for (int mm = 0; mm < 2; ++mm)
#pragma unroll
                        for (int bj = 0; bj < 2; ++bj) { const int row = row0 + ai * HALF + (2 * mh + mm) * 16, c = col0 + bj * HALF;
                            gw[mm][bj] = *(const u32x4*)(P + (size_t)row * NPROJ + gcol + c);
                            if (rmw) { const float* mp = MG + (size_t)row * DM + c; m0[mm][bj] = *(const f32x4*)mp; m1[mm][bj] = *(const f32x4*)(mp + 4); }
                            else { m0[mm][bj] = (f32x4){0.f, 0.f, 0.f, 0.f}; m1[mm][bj] = (f32x4){0.f, 0.f, 0.f, 0.f}; } }
#pragma unroll
                    for (int mm = 0; mm < 2; ++mm)
#pragma unroll
                        for (int bj = 0; bj < 2; ++bj) { const int m = 2 * mh + mm; const int row = row0 + ai * HALF + m * 16, c = col0 + bj * HALF;
                            const u32x4 g = gw[mm][bj]; f32x4 r0 = m0[mm][bj], r1 = m1[mm][bj];
                            r0[0] += sigm(lo16(g.x)) * acc[ai][bj][m][0][0]; r0[1] += sigm(hi16(g.x)) * acc[ai][bj][m][0][1];
                            r0[2] += sigm(lo16(g.y)) * acc[ai][bj][m][0][2]; r0[3] += sigm(hi16(g.y)) * acc[ai][bj][m][0][3];
                            r1[0] += sigm(lo16(g.z)) * acc[ai][bj][m][1][0]; r1[1] += sigm(hi16(g.z)) * acc[ai][bj][m][1][1];
                            r1[2] += sigm(lo16(g.w)) * acc[ai][bj][m][1][2]; r1[3] += sigm(hi16(g.w)) * acc[ai][bj][m][1][3];
                            float* mp = MG + (size_t)row * DM + c; *(f32x4*)mp = r0; *(f32x4*)(mp + 4) = r1; }
                }
        } else {
            const int col0 = (u.pn - 24) * HALF + wc * 32 + 8 * fq;
#pragma unroll
            for (int ai = 0; ai < 2; ++ai) {
                u32x4 gw[4]; f32x4 m0[4], m1[4];
#pragma unroll
                for (int m = 0; m < 4; ++m) { const int row = row0 + ai * HALF + m * 16;
                    gw[m] = *(const u32x4*)(P + (size_t)row * NPROJ + C_GS5 + col0);
                    const float* mp = MG + (size_t)row * DM + col0; m0[m] = *(const f32x4*)mp; m1[m] = *(const f32x4*)(mp + 4); }
#pragma unroll
                for (int m = 0; m < 4; ++m) { const int row = row0 + ai * HALF + m * 16; const u32x4 g = gw[m];
                    float r[8];
                    r[0] = m0[m][0] + sigm(lo16(g.x)) * acc[ai][0][m][0][0] * sigm(acc[ai][1][m][0][0]);
                    r[1] = m0[m][1] + sigm(hi16(g.x)) * acc[ai][0][m][0][1] * sigm(acc[ai][1][m][0][1]);
                    r[2] = m0[m][2] + sigm(lo16(g.y)) * acc[ai][0][m][0][2] * sigm(acc[ai][1][m][0][2]);
                    r[3] = m0[m][3] + sigm(hi16(g.y)) * acc[ai][0][m][0][3] * sigm(acc[ai][1][m][0][3]);
                    r[4] = m1[m][0] + sigm(lo16(g.z)) * acc[ai][0][m][1][0] * sigm(acc[ai][1][m][1][0]);
                    r[5] = m1[m][1] + sigm(hi16(g.z)) * acc[ai][0][m][1][1] * sigm(acc[ai][1][m][1][1]);
                    r[6] = m1[m][2] + sigm(lo16(g.w)) * acc[ai][0][m][1][2] * sigm(acc[ai][1][m][1][2]);
                    r[7] = m1[m][3] + sigm(hi16(g.w)) * acc[ai][0][m][1][3] * sigm(acc[ai][1][m][1][3]);
                    u32x4 w; w.x = pk2(r[0], r[1]); w.y = pk2(r[2], r[3]); w.z = pk2(r[4], r[5]); w.w = pk2(r[6], r[7]);
                    *(u32x4*)(MBF + (size_t)row * DM + col0) = w; }
            }
        }
    }
};
}

struct Args { const float* in[30]; float* out; unsigned char* ws; int ph_lo, ph_hi; };
enum { I_X = 0, I_C, I_ADAW, I_ADAB, I_WIN, I_CONVW, I_WCO, I_LRE, I_LIM, I_BRE, I_BIM, I_CRE, I_CIM, I_S5D, I_LOGDT, I_WS5V, I_WS5G, I_WSB,
       I_GLAWG, I_GLABG, I_GLANG, I_WGLA, I_WO, I_LN1G, I_LN1B, I_FFG, I_FFU, I_FFD, I_LN2G, I_LN2B };

__device__ __forceinline__ void tr_item(const float* srcp, int ld, int k0, bf16_t* WT, int Kd, int n0, float* scr, int lane) {
    const int r4 = lane >> 4, n4 = (lane & 15) * 4;
    f32x4 v[16];
#pragma unroll
    for (int i = 0; i < 16; ++i) v[i] = srcp ? *(const f32x4*)(srcp + (size_t)(k0 + 4 * i + r4) * ld) : (f32x4){0.f, 0.f, 0.f, 0.f};
#pragma unroll
    for (int i = 0; i < 16; ++i) { float* d = scr + (4 * i + r4) * 65 + n4; d[0] = v[i][0]; d[1] = v[i][1]; d[2] = v[i][2]; d[3] = v[i][3]; }
    __builtin_amdgcn_s_waitcnt(0); asm volatile("" ::: "memory");
    const int c = lane & 7;
#pragma unroll
    for (int j = 0; j < 8; ++j) { const int n = (lane >> 3) + 8 * j; const float* s = scr + (8 * c) * 65 + n;
        u32x4 o; o.x = pk2(s[0 * 65], s[1 * 65]); o.y = pk2(s[2 * 65], s[3 * 65]); o.z = pk2(s[4 * 65], s[5 * 65]); o.w = pk2(s[6 * 65], s[7 * 65]);
        *(u32x4*)(WT + (size_t)(n0 + n) * Kd + k0 + 8 * c) = o; }
    __builtin_amdgcn_s_waitcnt(0); asm volatile("" ::: "memory");
}

__device__ __forceinline__ void p0_transposes(const Args& a, unsigned char* smem, int gw, int ngw, int wave, int lane) {
    float* scr = (float*)(smem + wave * 16640);
    constexpr int C0 = 32 * 289, C1 = 16 * 160, C2 = 32 * 32, C3 = 32 * 176, C4 = 88 * 32, CL = C0 + C1 + C2 + C3 + C4;
    for (int it = gw; it < 2 * CL; it += ngw) {
        const int l = it / CL; int r = it % CL;
        unsigned char* wl = a.ws + WS_W + (size_t)l * W_LAYER;
        const int nl = (lane & 15) * 4;
        if (r < C0) { const int kb = r / 289, nb = r % 289, j = nb * 64 + nl;
            const float* base = a.in[I_WIN] + (size_t)l * DM * NIN;
            const float* sp = j < 10240 ? base + j : (j < 18432 ? base + j + 16 : (j < 18448 ? base + (j - 8192) : nullptr));
            tr_item(sp, NIN, kb * 64, (bf16_t*)(wl + WO_WIN), DM, nb * 64, scr, lane); continue; }
        r -= C0;
        if (r < C1) { const int kb = r / 160, nb = r % 160, j = nb * 64 + nl; const float* sp;
            if (j < 2048) sp = a.in[I_WCO] + (size_t)l * 1024 * DM + j;
            else if (j < 4096) sp = a.in[I_WSB] + (size_t)l * 1024 * DM + (j - 2048);
            else if (j < 6144) sp = a.in[I_WGLA] + (size_t)l * 1024 * DM + (j - 4096);
            else { const int rr = j - 6144, tile = rr >> 8, w = rr & 255; sp = (w < 128 ? a.in[I_WS5V] : a.in[I_WS5G]) + (size_t)l * 1024 * DM + tile * 128 + (w & 127); }
            tr_item(sp, DM, kb * 64, (bf16_t*)(wl + WO_WBR), 1024, nb * 64, scr, lane); continue; }
        r -= C1;
        if (r < C2) { const int kb = r / 32, nb = r % 32, j = nb * 64 + nl;
            tr_item(a.in[I_WO] + (size_t)l * DM * DM + j, DM, kb * 64, (bf16_t*)(wl + WO_WO), DM, nb * 64, scr, lane); continue; }
        r -= C2;
        if (r < C3) { const int kb = r / 176, nb = r % 176, j = nb * 64 + nl; const int tile = j >> 8, w = j & 255;
            const float* sp = (w < 128 ? a.in[I_FFG] : a.in[I_FFU]) + (size_t)l * DM * DFF + tile * 128 + (w & 127);
            tr_item(sp, DFF, kb * 64, (bf16_t*)(wl + WO_WGU), DM, nb * 64, scr, lane); continue; }
        r -= C3;
        { const int kb = r / 32, nb = r % 32, j = nb * 64 + nl;
            tr_item(a.in[I_FFD] + (size_t)l * DFF * DM + j, DM, kb * 64, (bf16_t*)(wl + WO_WD), DFF, nb * 64, scr, lane); }
    }
}

__device__ __forceinline__ void p0_adaln_item(const Args& a, unsigned char* smem, int item, int tid) {
    const int lane = tid & 63, w = tid >> 6;
    float* sc = (float*)smem;
    float* red = (float*)(smem + 32768);
    const int l = item / 192, col0 = (item % 192) * 64;
    const float* wp = a.in[I_ADAW] + (size_t)l * DM * 12288 + col0 + lane;
    float acc0 = 0.f, acc1 = 0.f, acc2 = 0.f, acc3 = 0.f;
    const int k0 = w * 256;
#pragma unroll 32
    for (int k = k0; k < k0 + 256; ++k) { const float wv = wp[(size_t)k * 12288];
        acc0 += sc[k] * wv; acc1 += sc[2048 + k] * wv; acc2 += sc[4096 + k] * wv; acc3 += sc[6144 + k] * wv; }
    red[(w * 4 + 0) * 64 + lane] = acc0; red[(w * 4 + 1) * 64 + lane] = acc1; red[(w * 4 + 2) * 64 + lane] = acc2; red[(w * 4 + 3) * 64 + lane] = acc3;
    __syncthreads();
    if (tid < 256) { const int b = tid >> 6, col = tid & 63; float s = a.in[I_ADAB][l * 12288 + col0 + col];
#pragma unroll
        for (int ww = 0; ww < 8; ++ww) s += red[(ww * 4 + b) * 64 + col];
        ((float*)(a.ws + WS_MOD))[(size_t)(l * 4 + b) * 12288 + col0 + col] = s; }
    __syncthreads();
}

__device__ __forceinline__ void p0_s5pre_item(const Args& a, unsigned char* smem, int item, int tid) {
    const int l = item >> 6, g = item & 63, lg = l * 64 + g;
    float2* Bb = (float2*)(smem + 40960);
    float2* Cc = Bb + 1024;
    float2* Pw = Cc + 1024;
    float* Kt = (float*)(Pw + 17 * 64);
    float2* Ff = (float2*)(Kt + 4096);
    unsigned char* s5w = a.ws + WS_S5M + (size_t)l * S5_LAYER;
    if (tid < 64) { const int p = tid;
        const double dt = exp((double)a.in[I_LOGDT][lg]);
        const double lr = (double)a.in[I_LRE][lg * 64 + p], li = (double)a.in[I_LIM][lg * 64 + p];
        const double rev = li * dt * 0.15915494309189535;
        double abr = 0.0, abi = 0.0;
        for (int tau = 0; tau <= 16; ++tau) { const double mg = exp(lr * dt * tau); double x = rev * tau; x -= rint(x);
            const double s = sinpi(2.0 * x), c = cospi(2.0 * x);
            Pw[tau * 64 + p] = make_float2((float)(mg * c), (float)(mg * s));
            if (tau == 1) { abr = mg * c; abi = mg * s; } }
        const double den = lr * lr + li * li, nr = abr - 1.0, ni = abi;
        Ff[p] = make_float2((float)((nr * lr + ni * li) / den), (float)((ni * lr - nr * li) / den));
        ((float2*)(s5w + S5O_A16))[g * 64 + p] = Pw[16 * 64 + p];
    }
    __syncthreads();
    for (int e = tid; e < 1024; e += 512) { const int p = e >> 4;
        const float br = a.in[I_BRE][(size_t)lg * 1024 + e], bi = a.in[I_BIM][(size_t)lg * 1024 + e]; const float2 f = Ff[p];
        Bb[e] = make_float2(f.x * br - f.y * bi, f.x * bi + f.y * br);
        Cc[e] = make_float2(a.in[I_CRE][(size_t)lg * 1024 + e], a.in[I_CIM][(size_t)lg * 1024 + e]); }
    __syncthreads();
    for (int idx = tid; idx < 4096; idx += 512) { const int tau = idx >> 8, h = (idx >> 4) & 15, hp = idx & 15; float s = 0.f;
        for (int p = 0; p < 64; ++p) { const float2 c = Cc[h * 64 + p], w = Pw[tau * 64 + p], b = Bb[p * 16 + hp];
            const float cr = c.x * w.x - c.y * w.y, ci = c.x * w.y + c.y * w.x; s += cr * b.x - ci * b.y; }
        Kt[idx] = s; }
    __syncthreads();
    {
        bf16_t* MR = (bf16_t*)(s5w + S5O_MROW) + (size_t)g * 256 * 384;
        for (int e2 = tid; e2 < 256 * 192; e2 += 512) { const int n = e2 / 192, k2 = (e2 % 192) * 2; const int i = n >> 4, h = n & 15; float v[2];
#pragma unroll
            for (int u = 0; u < 2; ++u) { const int k = k2 + u;
                if (k < 256) { const int j = k >> 4, hp = k & 15; v[u] = (i >= j) ? Kt[(i - j) * 256 + h * 16 + hp] : 0.f; }
                else if (k < 320) { const int p = k - 256; const float2 c = Cc[h * 64 + p], w = Pw[(i + 1) * 64 + p]; v[u] = c.x * w.x - c.y * w.y; }
                else { const int p = k - 320; const float2 c = Cc[h * 64 + p], w = Pw[(i + 1) * 64 + p]; v[u] = -(c.x * w.y + c.y * w.x); } }
            *(unsigned*)(MR + (size_t)n * 384 + k2) = pk2(v[0], v[1]); }
        bf16_t* MI = (bf16_t*)(s5w + S5O_MIN) + (size_t)g * 128 * 256;
        for (int e2 = tid; e2 < 128 * 128; e2 += 512) { const int n2 = e2 >> 7, k2 = (e2 & 127) * 2; const int p = n2 & 63; float v[2];
#pragma unroll
            for (int u = 0; u < 2; ++u) { const int k = k2 + u, j = k >> 4, hp = k & 15; const float2 w = Pw[(15 - j) * 64 + p], b = Bb[p * 16 + hp];
                v[u] = (n2 < 64) ? (w.x * b.x - w.y * b.y) : (w.x * b.y + w.y * b.x); }
            *(unsigned*)(MI + (size_t)n2 * 256 + k2) = pk2(v[0], v[1]); }
    }
    __syncthreads();
}

__device__ __forceinline__ void ln_stats(const f32x4 (&v)[8], float& mean, float& rstd) {
    float s = 0.f;
#pragma unroll
    for (int j = 0; j < 8; ++j) s += (v[j][0] + v[j][1]) + (v[j][2] + v[j][3]);
    mean = wave_sum(s) * (1.f / DM); float q = 0.f;
#pragma unroll
    for (int j = 0; j < 8; ++j) { const f32x4 d = v[j] - mean; q += (d[0] * d[0] + d[1] * d[1]) + (d[2] * d[2] + d[3] * d[3]); }
    rstd = rsqrtf(wave_sum(q) * (1.f / DM) + 1e-5f);
}
__device__ __forceinline__ void ln_mod_store(const f32x4 (&v)[8], const float* sc, const float* sh, bf16_t* hrow, int lane) {
    float mean, rstd; ln_stats(v, mean, rstd);
#pragma unroll
    for (int j = 0; j < 8; ++j) { const int c = 4 * lane + 256 * j; const f32x4 s = *(const f32x4*)(sc + c), t = *(const f32x4*)(sh + c);
        const f32x4 y = (v[j] - mean) * rstd * (s + 1.f) + t; u32x2 w; w.x = pk2(y[0], y[1]); w.y = pk2(y[2], y[3]); *(u32x2*)(hrow + c) = w; }
}
__device__ __forceinline__ void ln_phase(const float* in, const float* g, const float* bta, float* xo, const float* modsc, const float* modsh, bf16_t* H, int gw, int ngw, int lane) {
    for (int m = gw; m < MTOK; m += ngw) {
        f32x4 v[8];
#pragma unroll
        for (int j = 0; j < 8; ++j) v[j] = *(const f32x4*)(in + (size_t)m * DM + 4 * lane + 256 * j);
        if (g) { float mean, rstd; ln_stats(v, mean, rstd);
#pragma unroll
            for (int j = 0; j < 8; ++j) { const int c = 4 * lane + 256 * j; const f32x4 gg = *(const f32x4*)(g + c), bb = *(const f32x4*)(bta + c);
                v[j] = (v[j] - mean) * rstd * gg + bb; *(f32x4*)(xo + (size_t)m * DM + c) = v[j]; } }
        if (modsc) { const int b = m >> 11; ln_mod_store(v, modsc + (size_t)b * 12288, modsh + (size_t)b * 12288, H + (size_t)m * DM, lane); }
    }
}

__device__ __forceinline__ void conv_item(const bf16_t* __restrict__ P, bf16_t* __restrict__ BR, const float* __restrict__ cw, int it, int tid) {
    const int idx = it * 512 + tid, m = idx >> 7, c8 = (idx & 127) * 8, t = m & (SEQ - 1);
    const bf16_t* pr = P + (size_t)m * NPROJ;
    float accv[8];
#pragma unroll
    for (int i = 0; i < 8; ++i) accv[i] = 0.f;
#pragma unroll
    for (int j = 0; j < 3; ++j) { const int dtk = 2 - j; if (t - dtk < 0) continue;
        const bf16_t* pj = pr - (size_t)dtk * NPROJ;
        const u32x4 cc = *(const u32x4*)(pj + C_CVC + c8), xx = *(const u32x4*)(pj + C_CVX + c8);
        const f32x4 w0 = *(const f32x4*)(cw + j * 1024 + c8), w1 = *(const f32x4*)(cw + j * 1024 + c8 + 4);
        accv[0] += w0[0] * lo16(cc.x) * lo16(xx.x); accv[1] += w0[1] * hi16(cc.x) * hi16(xx.x);
        accv[2] += w0[2] * lo16(cc.y) * lo16(xx.y); accv[3] += w0[3] * hi16(cc.y) * hi16(xx.y);
        accv[4] += w1[0] * lo16(cc.z) * lo16(xx.z); accv[5] += w1[1] * hi16(cc.z) * hi16(xx.z);
        accv[6] += w1[2] * lo16(cc.w) * lo16(xx.w); accv[7] += w1[3] * hi16(cc.w) * hi16(xx.w); }
    const u32x4 bb = *(const u32x4*)(pr + C_CVB + c8);
    u32x4 o; o.x = pk2(accv[0] * lo16(bb.x), accv[1] * hi16(bb.x)); o.y = pk2(accv[2] * lo16(bb.y), accv[3] * hi16(bb.y));
    o.z = pk2(accv[4] * lo16(bb.z), accv[5] * hi16(bb.z)); o.w = pk2(accv[6] * lo16(bb.w), accv[7] * hi16(bb.w));
    *(u32x4*)(BR + (size_t)m * NBR + BR_CONV + c8) = o;
}

__device__ __forceinline__ void lr_item(const bf16_t* Hh, const bf16_t* Wlr, float* LR, int it, int lane) {
    const int c16 = lane & 15, q = lane >> 4;
    const bf16_t* ap = Hh + (size_t)(16 * it + c16) * DM + 8 * q; const bf16_t* bp = Wlr + (size_t)c16 * DM + 8 * q;
    f32x4 acc = {0.f, 0.f, 0.f, 0.f};
#pragma unroll 1
    for (int k0 = 0; k0 < 64; k0 += 8) { bf16x8 af[8], bfr[8];
#pragma unroll
        for (int u = 0; u < 8; ++u) { af[u] = *(const bf16x8*)(ap + 32 * (k0 + u)); bfr[u] = *(const bf16x8*)(bp + 32 * (k0 + u)); }
#pragma unroll
        for (int u = 0; u < 8; ++u) acc = MFMA16(af[u], bfr[u], acc); }
#pragma unroll
    for (int j = 0; j < 4; ++j) LR[(size_t)(16 * it + 4 * q + j) * 16 + c16] = acc[j];
}

__device__ __forceinline__ void s5a_item(const bf16_t* __restrict__ P, const bf16_t* __restrict__ MIN, float* __restrict__ SLOC, int wi, int lane) {
    const int g = wi >> 5, ct = wi & 31, c16 = lane & 15, q = lane >> 4;
    const int cc = ct * 16 + c16, b = cc >> 7, c = cc & 127;
    bf16x8 bf[8];
#pragma unroll
    for (int ks = 0; ks < 8; ++ks) bf[ks] = *(const bf16x8*)(P + (size_t)(b * SEQ + c * 16 + 2 * ks + (q >> 1)) * NPROJ + C_S5U + g * 16 + (q & 1) * 8);
    const bf16_t* Mg = MIN + (size_t)g * 128 * 256;
    float* out = SLOC + ((size_t)(b * 128 + c) * 64 + g) * 128;
#pragma unroll
    for (int rt = 0; rt < 8; ++rt) { f32x4 acc = {0.f, 0.f, 0.f, 0.f};
#pragma unroll
        for (int ks = 0; ks < 8; ++ks) { const bf16x8 af = *(const bf16x8*)(Mg + (size_t)(16 * rt + c16) * 256 + 32 * ks + 8 * q); acc = MFMA16(af, bf[ks], acc); }
        *(f32x4*)(out + 16 * rt + 4 * q) = acc; }
}

__device__ __forceinline__ void s5c_item(const bf16_t* __restrict__ P, const bf16_t* __restrict__ MROW, const bf16_t* __restrict__ SPREV, const float* __restrict__ dsk, bf16_t* __restrict__ BR, int wi, int lane) {
    const int g = wi >> 5, ct = wi & 31, c16 = lane & 15, q = lane >> 4;
    const int cc = ct * 16 + c16, b = cc >> 7, c = cc & 127;
    bf16x8 bf[12];
#pragma unroll
    for (int ks = 0; ks < 8; ++ks) bf[ks] = *(const bf16x8*)(P + (size_t)(b * SEQ + c * 16 + 2 * ks + (q >> 1)) * NPROJ + C_S5U + g * 16 + (q & 1) * 8);
    const bf16_t* sp = SPREV + ((size_t)(b * 128 + c) * 64 + g) * 128;
#pragma unroll
    for (int ks = 0; ks < 4; ++ks) bf[8 + ks] = *(const bf16x8*)(sp + 32 * ks + 8 * q);
    const bf16_t* Mg = MROW + (size_t)g * 256 * 384;
    const f32x4 dv = *(const f32x4*)(dsk + g * 16 + 4 * q);
#pragma unroll
    for (int i = 0; i < 16; ++i) { f32x4 acc = {0.f, 0.f, 0.f, 0.f};
        const bf16_t* mrow = Mg + (size_t)(16 * i + c16) * 384 + 8 * q;
#pragma unroll
        for (int ks = 0; ks < 8; ++ks) if (ks <= (i >> 1)) { const bf16x8 af = *(const bf16x8*)(mrow + 32 * ks); acc = MFMA16(af, bf[ks], acc); }
#pragma unroll
        for (int ks = 8; ks < 12; ++ks) { const bf16x8 af = *(const bf16x8*)(mrow + 32 * ks); acc = MFMA16(af, bf[ks], acc); }
        const size_t m = (size_t)b * SEQ + c * 16 + i;
        const u32x2 uw = *(const u32x2*)(P + m * NPROJ + C_S5U + g * 16 + 4 * q);
        const float y0 = acc[0] + dv[0] * lo16(uw.x), y1 = acc[1] + dv[1] * hi16(uw.x), y2 = acc[2] + dv[2] * lo16(uw.y), y3 = acc[3] + dv[3] * hi16(uw.y);
        u32x2 o; o.x = pk2(gelu_tanh(y0), gelu_tanh(y1)); o.y = pk2(gelu_tanh(y2), gelu_tanh(y3));
        *(u32x2*)(BR + m * NBR + BR_S5 + g * 16 + 4 * q) = o; }
}

__device__ __forceinline__ void stage_vt64(const bf16_t* P, size_t m0, int vcol0, bf16_t* VT, int tid) {
#pragma unroll
    for (int i = 0; i < 4; ++i) { const int id = tid + 512 * i, t = id >> 5, v8 = (id & 31) * 8;
        const u32x4 vv = *(const u32x4*)(P + (m0 + t) * NPROJ + vcol0 + v8);
        VT[(v8 + 0) * 72 + t] = (bf16_t)(vv.x & 0xffffu); VT[(v8 + 1) * 72 + t] = (bf16_t)(vv.x >> 16);
        VT[(v8 + 2) * 72 + t] = (bf16_t)(vv.y & 0xffffu); VT[(v8 + 3) * 72 + t] = (bf16_t)(vv.y >> 16);
        VT[(v8 + 4) * 72 + t] = (bf16_t)(vv.z & 0xffffu); VT[(v8 + 5) * 72 + t] = (bf16_t)(vv.z >> 16);
        VT[(v8 + 6) * 72 + t] = (bf16_t)(vv.w & 0xffffu); VT[(v8 + 7) * 72 + t] = (bf16_t)(vv.w >> 16); }
}

__device__ __forceinline__ void glaa_item(const bf16_t* P, const float* LR, const float* wgate, const float* bgate, float* BCUM, float* AEND, float* LCT, unsigned char* smem, int it, int tid) {
    const int bh = it >> 5, cn = it & 31, b = bh >> 2, h = bh & 3; const size_t m0 = (size_t)b * SEQ + cn * 64;
    const int lane = tid & 63, w = tid >> 6, c16 = lane & 15, q = lane >> 4;
    float* lrs = (float*)smem;
    float* part = (float*)(smem + 4096);
    bf16_t* KdT = (bf16_t*)(smem + 8192);
    bf16_t* VT = (bf16_t*)(smem + 8192 + 18432);
    if (tid < 256) *(f32x4*)(lrs + 4 * tid) = *(const f32x4*)(LR + m0 * 16 + 4 * tid);
    stage_vt64(P, m0, C_GLV + h * 256, VT, tid);
    __syncthreads();
    const int k = tid & 127, tg = tid >> 7;
    float wg[16];
#pragma unroll
    for (int r = 0; r < 16; ++r) wg[r] = wgate[r * 512 + h * 128 + k];
    const float bias = bgate[h * 128 + k];
    float bl[16]; float run = 0.f;
#pragma unroll
    for (int tt = 0; tt < 16; ++tt) { const float* lr = lrs + (16 * tg + tt) * 16; float z = bias;
#pragma unroll
        for (int r = 0; r < 16; ++r) z += lr[r] * wg[r];
        const float la = (fminf(z, 0.f) - __logf(1.f + __expf(-fabsf(z)))) * (1.f / 16.f);
        run += la; bl[tt] = run; }
    part[tg * 128 + k] = run;
    __syncthreads();
    float off = 0.f, bend = 0.f;
#pragma unroll
    for (int g2 = 0; g2 < 4; ++g2) { const float pv = part[g2 * 128 + k]; bend += pv; if (g2 < tg) off += pv; }
    if (tg == 0) AEND[(size_t)(bh * 32 + cn) * 128 + k] = __expf(bend);
    unsigned kd[8];
#pragma unroll
    for (int tt = 0; tt < 16; tt += 2) {
        const float b0 = bl[tt] + off, b1 = bl[tt + 1] + off; const size_t t0 = m0 + 16 * tg + tt;
        BCUM[t0 * 512 + h * 128 + k] = b0; BCUM[(t0 + 1) * 512 + h * 128 + k] = b1;
        const float k0v = bf2f(P[t0 * NPROJ + C_GLK + h * 128 + k]), k1v = bf2f(P[(t0 + 1) * NPROJ + C_GLK + h * 128 + k]);
        kd[tt >> 1] = pk2(k0v * __expf(bend - b0), k1v * __expf(bend - b1)); }
    { u32x4 w0, w1; w0.x = kd[0]; w0.y = kd[1]; w0.z = kd[2]; w0.w = kd[3]; w1.x = kd[4]; w1.y = kd[5]; w1.z = kd[6]; w1.w = kd[7];
      *(u32x4*)(KdT + k * 72 + 16 * tg) = w0; *(u32x4*)(KdT + k * 72 + 16 * tg + 8) = w1; }
    __syncthreads();
    float* out = LCT + (size_t)(bh * 32 + cn) * 32768;
#pragma unroll
    for (int vi = 0; vi < 2; ++vi) { const int vt = 2 * w + vi;
        const bf16x8 a0 = *(const bf16x8*)(VT + (16 * vt + c16) * 72 + 8 * q), a1 = *(const bf16x8*)(VT + (16 * vt + c16) * 72 + 32 + 8 * q);
#pragma unroll
        for (int kt = 0; kt < 8; ++kt) { f32x4 acc = {0.f, 0.f, 0.f, 0.f};
            const bf16x8 b0 = *(const bf16x8*)(KdT + (16 * kt + c16) * 72 + 8 * q), b1 = *(const bf16x8*)(KdT + (16 * kt + c16) * 72 + 32 + 8 * q);
            acc = MFMA16(a0, b0, acc); acc = MFMA16(a1, b1, acc);
#pragma unroll
            for (int j = 0; j < 4; ++j) out[(size_t)(16 * vt + 4 * q + j) * 128 + 16 * kt + c16] = acc[j]; } }
    __syncthreads();
}

__device__ __forceinline__ void glac_item(const bf16_t* __restrict__ P, const float* __restrict__ BCUM, const bf16_t* __restrict__ SNT, const float* __restrict__ gn,
                                          bf16_t* __restrict__ BR, unsigned char* smem, int it, int tid) {
    const int bh = it >> 5, cn = it & 31, b = bh >> 2, h = bh & 3; const size_t m0 = (size_t)b * SEQ + cn * 64;
    const int lane = tid & 63, w = tid >> 6, c16 = lane & 15, q = lane >> 4;
    bf16_t* Qd = (bf16_t*)smem;
    bf16_t* Ki = (bf16_t*)(smem + 17408);
    bf16_t* Pm = (bf16_t*)(smem + 34816);
    bf16_t* VT = (bf16_t*)(smem + 44032);
    float* st = (float*)(smem + 44032 + 36864);
    bf16_t* On = (bf16_t*)(smem + 81920);
    stage_vt64(P, m0, C_GLV + h * 256, VT, tid);
#pragma unroll
    for (int i = 0; i < 2; ++i) { const int id = tid + 512 * i, t = id >> 4, k8 = (id & 15) * 8; const size_t m = m0 + t;
        const f32x4 b0 = *(const f32x4*)(BCUM + m * 512 + h * 128 + k8), b1 = *(const f32x4*)(BCUM + m * 512 + h * 128 + k8 + 4);
        const u32x4 qv = *(const u32x4*)(P + m * NPROJ + C_GLQ + h * 128 + k8), kv = *(const u32x4*)(P + m * NPROJ + C_GLK + h * 128 + k8);
        float e[8], qf[8], kf[8];
        e[0] = b0[0]; e[1] = b0[1]; e[2] = b0[2]; e[3] = b0[3]; e[4] = b1[0]; e[5] = b1[1]; e[6] = b1[2]; e[7] = b1[3];
        qf[0] = lo16(qv.x); qf[1] = hi16(qv.x); qf[2] = lo16(qv.y); qf[3] = hi16(qv.y); qf[4] = lo16(qv.z); qf[5] = hi16(qv.z); qf[6] = lo16(qv.w); qf[7] = hi16(qv.w);
        kf[0] = lo16(kv.x); kf[1] = hi16(kv.x); kf[2] = lo16(kv.y); kf[3] = hi16(kv.y); kf[4] = lo16(kv.z); kf[5] = hi16(kv.z); kf[6] = lo16(kv.w); kf[7] = hi16(kv.w);
        u32x4 qo, ko;
        qo.x = pk2(qf[0] * QSCALE * __expf(e[0]), qf[1] * QSCALE * __expf(e[1])); qo.y = pk2(qf[2] * QSCALE * __expf(e[2]), qf[3] * QSCALE * __expf(e[3]));
        qo.z = pk2(qf[4] * QSCALE * __expf(e[4]), qf[5] * QSCALE * __expf(e[5])); qo.w = pk2(qf[6] * QSCALE * __expf(e[6]), qf[7] * QSCALE * __expf(e[7]));
        ko.x = pk2(kf[0] * __expf(-e[0]), kf[1] * __expf(-e[1])); ko.y = pk2(kf[2] * __expf(-e[2]), kf[3] * __expf(-e[3]));
        ko.z = pk2(kf[4] * __expf(-e[4]), kf[5] * __expf(-e[5])); ko.w = pk2(kf[6] * __expf(-e[6]), kf[7] * __expf(-e[7]));
        *(u32x4*)(Qd + t * 136 + k8) = qo; *(u32x4*)(Ki + t * 136 + k8) = ko; }
    __syncthreads();
#pragma unroll
    for (int ti = 0; ti < 2; ++ti) { const int tile = 2 * w + ti, tt = tile >> 2, stl = tile & 3; f32x4 acc = {0.f, 0.f, 0.f, 0.f};
        if (stl <= tt) {
#pragma unroll
            for (int ks = 0; ks < 4; ++ks) { const bf16x8 af = *(const bf16x8*)(Qd + (16 * tt + c16) * 136 + 32 * ks + 8 * q), bfr = *(const bf16x8*)(Ki + (16 * stl + c16) * 136 + 32 * ks + 8 * q);
                acc = MFMA16(af, bfr, acc); } }
#pragma unroll
        for (int j = 0; j < 4; ++j) { const int t = 16 * tt + 4 * q + j, s = 16 * stl + c16; Pm[t * 72 + s] = (bf16_t)f2bf((s <= t) ? acc[j] : 0.f); } }
    __syncthreads();
    {
        const int tt = w & 3, vt0 = 8 * (w >> 2);
        bf16x8 pa[2], qa[4];
#pragma unroll
        for (int ks = 0; ks < 2; ++ks) pa[ks] = *(const bf16x8*)(Pm + (16 * tt + c16) * 72 + 32 * ks + 8 * q);
#pragma unroll
        for (int ks = 0; ks < 4; ++ks) qa[ks] = *(const bf16x8*)(Qd + (16 * tt + c16) * 136 + 32 * ks + 8 * q);
        const bf16_t* Sg = SNT + (size_t)(bh * 32 + cn) * 32768;
        f32x4 o[8];
#pragma unroll
        for (int vi = 0; vi < 8; ++vi) { const int vt = vt0 + vi; f32x4 acc = {0.f, 0.f, 0.f, 0.f};
#pragma unroll
            for (int ks = 0; ks < 2; ++ks) { const bf16x8 bfr = *(const bf16x8*)(VT + (16 * vt + c16) * 72 + 32 * ks + 8 * q); acc = MFMA16(pa[ks], bfr, acc); }
#pragma unroll
            for (int ks = 0; ks < 4; ++ks) { const bf16x8 bfr = *(const bf16x8*)(Sg + (size_t)(16 * vt + c16) * 128 + 32 * ks + 8 * q); acc = MFMA16(qa[ks], bfr, acc); }
            o[vi] = acc; }
        float s1[4], s2[4];
#pragma unroll
        for (int j = 0; j < 4; ++j) { float a1 = 0.f, a2 = 0.f;
#pragma unroll
            for (int vi = 0; vi < 8; ++vi) { a1 += o[vi][j]; a2 += o[vi][j] * o[vi][j]; }
#pragma unroll
            for (int x = 1; x < 16; x <<= 1) { a1 += __shfl_xor(a1, x); a2 += __shfl_xor(a2, x); }
            s1[j] = a1; s2[j] = a2; }
        if (c16 == 0) {
#pragma unroll
            for (int j = 0; j < 4; ++j) { st[((w >> 2) * 64 + 16 * tt + 4 * q + j) * 2] = s1[j]; st[((w >> 2) * 64 + 16 * tt + 4 * q + j) * 2 + 1] = s2[j]; } }
        __syncthreads();
#pragma unroll
        for (int j = 0; j < 4; ++j) { const int t = 16 * tt + 4 * q + j;
            const float a1 = st[t * 2] + st[(64 + t) * 2], a2 = st[t * 2 + 1] + st[(64 + t) * 2 + 1];
            const float mean = a1 * (1.f / 256.f), var = a2 * (1.f / 256.f) - mean * mean, rstd = rsqrtf(var + 1e-5f);
#pragma unroll
            for (int vi = 0; vi < 8; ++vi) On[t * 264 + 16 * (vt0 + vi) + c16] = (bf16_t)f2bf((o[vi][j] - mean) * rstd); }
    }
    __syncthreads();
#pragma unroll
    for (int i = 0; i < 4; ++i) { const int id = tid + 512 * i, t = id >> 5, v8 = (id & 31) * 8; const size_t m = m0 + t;
        const u32x4 ov = *(const u32x4*)(On + t * 264 + v8); const u32x4 rv = *(const u32x4*)(P + m * NPROJ + C_GLR + h * 256 + v8);
        const f32x4 g0 = *(const f32x4*)(gn + h * 256 + v8), g1 = *(const f32x4*)(gn + h * 256 + v8 + 4);
        u32x4 w4;
        w4.x = pk2(lo16(ov.x) * g0[0] * siluf_(lo16(rv.x)), hi16(ov.x) * g0[1] * siluf_(hi16(rv.x)));
        w4.y = pk2(lo16(ov.y) * g0[2] * siluf_(lo16(rv.y)), hi16(ov.y) * g0[3] * siluf_(hi16(rv.y)));
        w4.z = pk2(lo16(ov.z) * g1[0] * siluf_(lo16(rv.z)), hi16(ov.z) * g1[1] * siluf_(hi16(rv.z)));
        w4.w = pk2(lo16(ov.w) * g1[2] * siluf_(lo16(rv.w)), hi16(ov.w) * g1[3] * siluf_(hi16(rv.w)));
        *(u32x4*)(BR + m * NBR + BR_GLA + h * 256 + v8) = w4; }
    __syncthreads();
}

template <bool MASKED>
__device__ __forceinline__ void sb_weights(const f32x4 (&s)[4], int key0, int tq, int q, float& R, bf16x8& wA, bf16x8& wB) {
    constexpr float SC2 = QSCALE * 1.4426950408889634f;
    float z[4][4], c[4][4];
#pragma unroll
    for (int sb = 0; sb < 4; ++sb)
#pragma unroll
        for (int j = 0; j < 4; ++j) { z[sb][j] = s[sb][j] * SC2; const float sp = __builtin_amdgcn_logf(1.f + __builtin_amdgcn_exp2f(z[sb][j]));
            c[sb][j] = (!MASKED || (key0 + 16 * sb + 4 * q + j) < tq) ? sp : 0.f; }
    float aft[4], all[4];
#pragma unroll
    for (int sb = 0; sb < 4; ++sb) { c[sb][2] += c[sb][3]; c[sb][1] += c[sb][2]; c[sb][0] += c[sb][1];
        const float T = c[sb][0], ax = __shfl_xor(T, 16), bx = T + ax, cx = __shfl_xor(bx, 32);
        aft[sb] = ((q & 1) ? 0.f : ax) + ((q & 2) ? 0.f : cx); all[sb] = bx + cx; }
    float base[4];
    base[3] = R + aft[3]; base[2] = R + all[3] + aft[2]; base[1] = R + all[3] + all[2] + aft[1]; base[0] = R + all[3] + all[2] + all[1] + aft[0];
    R += (all[0] + all[1]) + (all[2] + all[3]);
    float wv[4][4];
#pragma unroll
    for (int sb = 0; sb < 4; ++sb)
#pragma unroll
        for (int j = 0; j < 4; ++j) { const float e = __builtin_amdgcn_exp2f(z[sb][j] - (c[sb][j] + base[sb]));
            wv[sb][j] = (!MASKED || (key0 + 16 * sb + 4 * q + j) < tq) ? e : 0.f; }
    union { bf16x8 v; unsigned u[4]; } a, b;
    a.u[0] = pk2(wv[0][0], wv[0][1]); a.u[1] = pk2(wv[0][2], wv[0][3]); a.u[2] = pk2(wv[1][0], wv[1][1]); a.u[3] = pk2(wv[1][2], wv[1][3]);
    b.u[0] = pk2(wv[2][0], wv[2][1]); b.u[1] = pk2(wv[2][2], wv[2][3]); b.u[2] = pk2(wv[3][0], wv[3][1]); b.u[3] = pk2(wv[3][2], wv[3][3]);
    wA = a.v; wB = b.v;
}

__device__ __forceinline__ void attn_unit(const bf16_t* P, bf16_t* BR, unsigned char* smem, int unit, int tid) {
    const int lane = tid & 63, w = tid >> 6, c16 = lane & 15, q = lane >> 4;
    bf16_t* KsB = (bf16_t*)smem;
    bf16_t* VTB = (bf16_t*)(smem + 34816);
    const int bh = unit >> 3, pr = unit & 7, b = bh >> 3, h = bh & 7;
    const int lkey = tid >> 4, ld8 = (tid & 15) * 8;
    const int keyA = lkey ^ (4 * (tid & 15)), keyB = keyA ^ 32;
    const bf16_t* Kg = P + (size_t)b * SEQ * NPROJ + C_SBK + h * 128 + ld8;
    const bf16_t* Vg = P + (size_t)b * SEQ * NPROJ + C_SBV + h * 128 + ld8;
    for (int half = 0; half < 2; ++half) {
        const int qb = half ? 15 - pr : pr;
        const int tq = qb * 128 + 16 * w + c16;
        const size_t mq = (size_t)b * SEQ + tq;
        bf16x8 qf[4];
#pragma unroll
        for (int ks = 0; ks < 4; ++ks) qf[ks] = *(const bf16x8*)(P + mq * NPROJ + C_SBQ + h * 128 + 32 * ks + 8 * q);
        f32x4 o[8];
#pragma unroll
        for (int d = 0; d < 8; ++d) o[d] = (f32x4){0.f, 0.f, 0.f, 0.f};
        float R = 0.f;
        const int nt = 2 * qb + 2;
        u32x4 pk0, pk1, pv0, pv1;
        { const size_t r0 = (size_t)((nt - 1) * 64 + lkey) * NPROJ, r1 = r0 + (size_t)32 * NPROJ;
          pk0 = *(const u32x4*)(Kg + r0); pk1 = *(const u32x4*)(Kg + r1); pv0 = *(const u32x4*)(Vg + r0); pv1 = *(const u32x4*)(Vg + r1); }
        for (int it = 0; it < nt; ++it) {
            const int kt = nt - 1 - it, key0 = kt * 64;
            bf16_t* Ks = KsB + (it & 1) * 8704; bf16_t* VT = VTB + (it & 1) * 9216;
            *(u32x4*)(Ks + lkey * 136 + ld8) = pk0; *(u32x4*)(Ks + (32 + lkey) * 136 + ld8) = pk1;
            { bf16_t* vd = VT + ld8 * 72 + keyA;
              vd[0 * 72] = (bf16_t)(pv0.x & 0xffffu); vd[1 * 72] = (bf16_t)(pv0.x >> 16); vd[2 * 72] = (bf16_t)(pv0.y & 0xffffu); vd[3 * 72] = (bf16_t)(pv0.y >> 16);
              vd[4 * 72] = (bf16_t)(pv0.z & 0xffffu); vd[5 * 72] = (bf16_t)(pv0.z >> 16); vd[6 * 72] = (bf16_t)(pv0.w & 0xffffu); vd[7 * 72] = (bf16_t)(pv0.w >> 16);
              vd = VT + ld8 * 72 + keyB;
              vd[0 * 72] = (bf16_t)(pv1.x & 0xffffu); vd[1 * 72] = (bf16_t)(pv1.x >> 16); vd[2 * 72] = (bf16_t)(pv1.y & 0xffffu); vd[3 * 72] = (bf16_t)(pv1.y >> 16);
              vd[4 * 72] = (bf16_t)(pv1.z & 0xffffu); vd[5 * 72] = (bf16_t)(pv1.z >> 16); vd[6 * 72] = (bf16_t)(pv1.w & 0xffffu); vd[7 * 72] = (bf16_t)(pv1.w >> 16); }
            __syncthreads();
            if (it + 1 < nt) { const size_t r0 = (size_t)((kt - 1) * 64 + lkey) * NPROJ, r1 = r0 + (size_t)32 * NPROJ;
                pk0 = *(const u32x4*)(Kg + r0); pk1 = *(const u32x4*)(Kg + r1); pv0 = *(const u32x4*)(Vg + r0); pv1 = *(const u32x4*)(Vg + r1); }
            const int tmin = qb * 128 + 16 * w;
            if (key0 <= tmin + 15) {
                f32x4 s[4];
#pragma unroll
                for (int sb = 0; sb < 4; ++sb) s[sb] = (f32x4){0.f, 0.f, 0.f, 0.f};
#pragma unroll
                for (int ks = 0; ks < 4; ++ks)
#pragma unroll
                    for (int sb = 0; sb < 4; ++sb) { const bf16x8 af = *(const bf16x8*)(Ks + (16 * sb + c16) * 136 + 32 * ks + 8 * q); s[sb] = MFMA16(af, qf[ks], s[sb]); }
                bf16x8 wA, wB;
                if (key0 + 64 <= tmin) sb_weights<false>(s, key0, tq, q, R, wA, wB);
                else sb_weights<true>(s, key0, tq, q, R, wA, wB);
#pragma unroll
                for (int dt = 0; dt < 8; ++dt) { const int m = (2 * dt + (c16 >> 3)) & 15; const bf16_t* vr = VT + (16 * dt + c16) * 72;
                    union { bf16x8 v; s16x4 hlf[2]; } aA, aB;
                    aA.hlf[0] = *(const s16x4*)(vr + 4 * (q ^ m)); aA.hlf[1] = *(const s16x4*)(vr + 4 * ((q + 4) ^ m));
                    aB.hlf[0] = *(const s16x4*)(vr + 4 * ((q + 8) ^ m)); aB.hlf[1] = *(const s16x4*)(vr + 4 * ((q + 12) ^ m));
                    o[dt] = MFMA16(aA.v, wA, o[dt]); o[dt] = MFMA16(aB.v, wB, o[dt]); }
            }
        }
#pragma unroll
        for (int dt = 0; dt < 8; ++dt) { u32x2 ov; ov.x = pk2(o[dt][0], o[dt][1]); ov.y = pk2(o[dt][2], o[dt][3]);
            *(u32x2*)(BR + mq * NBR + BR_SB + h * 128 + 16 * dt + 4 * q) = ov; }
    }
    __syncthreads();
}

#define XB_TMO      128
#define XB_XCNT(j)  (256  + 64 * (j))
#define XB_XSUB(j)  (1280 + 64 * (j))
#define XB_XGEN(j)  (2304 + 64 * (j))
#define XB_TOP      3328
#define XB_TOPGEN   3392
#define XCD_BAR_WORDS 3456
#define XB_SPIN_CAP (1u << 22)
__device__ __forceinline__ unsigned xb_ld(unsigned* p)              { return __hip_atomic_load(p, __ATOMIC_RELAXED, __HIP_MEMORY_SCOPE_AGENT); }
__device__ __forceinline__ unsigned xb_add(unsigned* p, unsigned v) { return __hip_atomic_fetch_add(p, v, __ATOMIC_RELAXED, __HIP_MEMORY_SCOPE_AGENT); }
__device__ __forceinline__ unsigned xb_xcc_id() { return (unsigned)__builtin_amdgcn_s_getreg((3 << 11) | 20) & 0xFu; }
#define XB_SPIN(cond, bar) do { unsigned _sp = 0; while (cond) { __builtin_amdgcn_s_sleep(1); \
    if ((++_sp & 255u) == 0u) { if (xb_ld(&(bar)[XB_TMO])) break; if (_sp > XB_SPIN_CAP) { atomicAdd(&(bar)[XB_TMO], 1u); break; } } } } while (0)
struct XcdBarrier { unsigned* bar; unsigned x; volatile LAS unsigned* st; };
__device__ __forceinline__ XcdBarrier xcd_barrier_post(unsigned* bar, volatile LAS unsigned* st) {
    XcdBarrier b; b.bar = bar; b.x = xb_xcc_id(); b.st = st;
    if (threadIdx.x == 0) (void)xb_add(&bar[XB_XCNT(b.x)], 1u);
    return b;
}
__device__ __forceinline__ void xcd_barrier_complete(unsigned* bar, unsigned x, unsigned& nloc, unsigned& nx) {
    const unsigned G = gridDim.x * gridDim.y * gridDim.z;
    unsigned sum, cnt, mine, sp = 0u;
    for (;;) {
        sum = 0u; cnt = 0u; mine = 0u;
#pragma unroll
        for (unsigned j = 0; j < 16; ++j) { const unsigned c = xb_ld(&bar[XB_XCNT(j)]); sum += c; cnt += (c > 0u) ? 1u : 0u; mine = (j == x) ? c : mine; }
        if (sum == G) break;
        __builtin_amdgcn_s_sleep(1);
        if ((++sp & 255u) == 0u) { if (xb_ld(&bar[XB_TMO])) break; if (sp > XB_SPIN_CAP) { atomicAdd(&bar[XB_TMO], 1u); break; } }
    }
    nloc = mine > 0u ? mine : 1u; nx = cnt > 0u ? cnt : 1u;
}
__device__ __forceinline__ void xcd_barrier(const XcdBarrier& b) {
    asm volatile("s_waitcnt vmcnt(0)" ::: "memory");
    __syncthreads();
    if (threadIdx.x == 0) {
        unsigned* bar = b.bar;
        __builtin_amdgcn_s_waitcnt(0);
        unsigned nloc = b.st[0], nx = b.st[1];
        if (nloc == 0u) { xcd_barrier_complete(bar, b.x, nloc, nx); b.st[0] = nloc; b.st[1] = nx; }
        const unsigned old = xb_add(&bar[XB_XSUB(b.x)], 1u);
        const unsigned gen = old / nloc;
        if (old + 1u == (gen + 1u) * nloc) {
            __builtin_amdgcn_fence(__ATOMIC_RELEASE, "agent");
            asm volatile("s_waitcnt vmcnt(0)" ::: "memory");
            const unsigned og = xb_add(&bar[XB_TOP], 1u);
            const unsigned tg = og / nx;
            if (og + 1u == (tg + 1u) * nx) xb_add(&bar[XB_TOPGEN], 1u);
            else XB_SPIN(xb_ld(&bar[XB_TOPGEN]) == tg, bar);
            __builtin_amdgcn_fence(__ATOMIC_ACQUIRE, "agent");
            xb_add(&bar[XB_XGEN(b.x)], 1u);
            asm volatile("s_waitcnt vmcnt(0)" ::: "memory");
        } else {
            XB_SPIN(xb_ld(&bar[XB_XGEN(b.x)]) == gen, bar);
            __builtin_amdgcn_fence(__ATOMIC_ACQUIRE, "agent");
            asm volatile("s_waitcnt vmcnt(0)" ::: "memory");
        }
    }
    __syncthreads();
}

constexpr int NPH = 23;
__global__ void __launch_bounds__(512, 2) mk_fwd(Args a) {
    extern __shared__ __attribute__((aligned(16))) unsigned char smem[];
    cg::grid_group grid = cg::this_grid();
    int tid = threadIdx.x, lane = tid & 63, wave = __builtin_amdgcn_readfirstlane(tid >> 6);
    int G = gridDim.x, bid = blockIdx.x, gw = bid * 8 + wave, ngw = G * 8;
    LAS unsigned char* lds = (LAS unsigned char*)smem;
    unsigned char* ws = a.ws;
    float* MOD = (float*)(ws + WS_MOD);
    bf16_t* H = (bf16_t*)(ws + WS_H); bf16_t* PROJ = (bf16_t*)(ws + WS_PROJ); bf16_t* ACT = (bf16_t*)(ws + WS_ACT);
    bf16_t* BR = (bf16_t*)(ws + WS_BR); float* Y = (float*)(ws + WS_Y); bf16_t* MBF = (bf16_t*)(ws + WS_MB); float* X1 = (float*)(ws + WS_X1);
    float* SLOC = (float*)(ws + WS_SLOC); bf16_t* SPREV = (bf16_t*)(ws + WS_SPREV); float* BCUM = (float*)(ws + WS_BCUM);
    float* AEND = (float*)(ws + WS_AEND); float* LRB = (float*)(ws + WS_LR); float* LCT = (float*)(ws + WS_LCT); bf16_t* SNT = (bf16_t*)(ws + WS_SNT);
    const int lo = a.ph_lo, hi = a.ph_hi;
    volatile LAS unsigned* xst = (volatile LAS unsigned*)(lds + LDS_BYTES - 64);
    if (tid == 0) { xst[0] = 0u; xst[1] = 0u; }
    __syncthreads();
    XcdBarrier xbar = xcd_barrier_post((unsigned*)(ws + WS_CTL), xst);
#define IN(k) (lo <= (k) && (k) < hi)
#ifndef DUP_BR
#define DUP_BR 0
#endif
#ifndef DUP_PROJ
#define DUP_PROJ 0
#endif
#ifndef DUP_GU
#define DUP_GU 0
#endif
#ifndef DUP_WO
#define DUP_WO 0
#endif
#ifndef DUP_DOWN
#define DUP_DOWN 0
#endif
#ifndef REPMASK
#define REPMASK 0u
#endif
#define REPS(kind) ((((unsigned)(REPMASK) >> (kind)) & 1u) ? 2 : 1)
#define PHASE(k, kind) if (IN(k)) for (int rep_ = 0; rep_ < REPS(kind); ++rep_, (rep_ < REPS(kind) ? (xcd_barrier(xbar), 0) : 0))
#define SEAM(k) do { if (IN(k) && IN((k) + 1)) { if ((k) == 0) grid.sync(); else xcd_barrier(xbar); } FRESH(); } while (0)
#define FRESH() do { tid = threadIdx.x; asm volatile("" : "+v"(tid)); lane = tid & 63; wave = __builtin_amdgcn_readfirstlane(tid >> 6); bid = blockIdx.x; asm volatile("" : "+s"(bid)); G = gridDim.x; asm volatile("" : "+s"(G)); gw = bid * 8 + wave; ngw = G * 8; } while (0)

    PHASE(0, 0) {
        {
            float* sc = (float*)smem;
            for (int i = tid; i < NB * DM; i += 512) sc[i] = siluf_(a.in[I_C][i]);
            __syncthreads();
            for (int it = bid; it < 384; it += G) p0_adaln_item(a, smem, it, tid);
            __syncthreads();
        }
        for (int it = (bid + 128) % G; it < 128; it += G) p0_s5pre_item(a, smem, it, tid);
        __syncthreads();
        p0_transposes(a, smem, gw, ngw, wave, lane);
        __syncthreads();
    }
    SEAM(0);

    for (int l = 0; l < 2; ++l) {
        const int pb = 1 + 11 * l;
        const unsigned char* wl = ws + WS_W + (size_t)l * W_LAYER;
        const unsigned char* s5w = ws + WS_S5M + (size_t)l * S5_LAYER;
        const float* modl = MOD + (size_t)l * 4 * 12288;
        const float* xin = l == 0 ? a.in[I_X] : a.out;
        PHASE(pb + 0, 1) if (l == 0) ln_phase(xin, nullptr, nullptr, nullptr, modl + 2048, modl, H, gw, ngw, lane);
        if (l == 0) SEAM(pb + 0);
        PHASE(pb + 1, 2) { pg8::Gemm g{H, (const bf16_t*)(wl + WO_WIN), DM, DM, DM}; pg8::StaticOrder S; S.init(MTOK, NPROJ, G, bid); S.dup = DUP_PROJ;
            pg8::EpiBf16 E{PROJ, NPROJ}; pg8::gemm_phase(lds, g, S, E, tid);
            if (wave < 2 && bid + G * wave < 512) lr_item(H, (const bf16_t*)(wl + WO_WIN) + (size_t)18432 * DM, LRB, bid + G * wave, lane); }
        SEAM(pb + 1);
        PHASE(pb + 2, 3) {
#ifndef REP_ATTN
#define REP_ATTN 1
#endif
#ifndef REP_GLAA
#define REP_GLAA 1
#endif
            for (int rr = 0; rr < REP_ATTN; ++rr) for (int u = bid; u < 256; u += G) attn_unit(PROJ, BR, smem, u, tid);
            for (int rr = 0; rr < REP_GLAA; ++rr) for (int it = bid; it < 512; it += G) glaa_item(PROJ, LRB, a.in[I_GLAWG] + (size_t)l * 16 * 512, a.in[I_GLABG] + l * 512, BCUM, AEND, LCT, smem, it, tid);
            for (int it = gw; it < 2048; it += ngw) s5a_item(PROJ, (const bf16_t*)(s5w + S5O_MIN), SLOC, it, lane);
            for (int it = bid; it < 2048; it += G) conv_item(PROJ, BR, a.in[I_CONVW] + (size_t)l * 3 * 1024, it, tid);
        }
        SEAM(pb + 2);
        PHASE(pb + 3, 4) {
            for (int it = bid; it < 32 + 1024; it += G) {
                if (it < 32) { const int idx = it * 512 + tid, b = idx >> 12, g = (idx >> 6) & 63, p = idx & 63;
                    const float2 ab = ((const float2*)(s5w + S5O_A16))[g * 64 + p]; float sr = 0.f, si = 0.f;
#pragma unroll 1
                    for (int c0 = 0; c0 < 128; c0 += 16) { float lr[16], li[16];
#pragma unroll
                        for (int u = 0; u < 16; ++u) { const size_t base = ((size_t)(b * 128 + c0 + u) * 64 + g) * 128; lr[u] = SLOC[base + p]; li[u] = SLOC[base + 64 + p]; }
#pragma unroll
                        for (int u = 0; u < 16; ++u) { const size_t base = ((size_t)(b * 128 + c0 + u) * 64 + g) * 128;
                            SPREV[base + p] = (bf16_t)f2bf(sr); SPREV[base + 64 + p] = (bf16_t)f2bf(si);
                            const float nr = ab.x * sr - ab.y * si + lr[u], ni = ab.x * si + ab.y * sr + li[u]; sr = nr; si = ni; } } }
                else { const int idx = (it - 32) * 512 + tid, bh = idx >> 15, e = idx & 32767, k = e & 127; float s = 0.f;
                    float av[32], lv[32];
#pragma unroll
                    for (int cn = 0; cn < 32; ++cn) { const size_t base = (size_t)(bh * 32 + cn); av[cn] = AEND[base * 128 + k]; lv[cn] = LCT[base * 32768 + e]; }
#pragma unroll
                    for (int cn = 0; cn < 32; ++cn) { const size_t base = (size_t)(bh * 32 + cn);
                        SNT[base * 32768 + e] = (bf16_t)f2bf(s); s = av[cn] * s + lv[cn]; } }
            }
        }
        SEAM(pb + 3);
        PHASE(pb + 4, 5) {
#ifndef REP_GLAC
#define REP_GLAC 1
#endif
#ifndef REP_S5C
#define REP_S5C 1
#endif
            for (int rr = 0; rr < REP_GLAC; ++rr) for (int it = bid; it < 512; it += G) glac_item(PROJ, BCUM, SNT, a.in[I_GLANG] + l * 1024, BR, smem, it, tid);
            for (int rr = 0; rr < REP_S5C; ++rr) for (int it = gw; it < 2048; it += ngw) s5c_item(PROJ, (const bf16_t*)(s5w + S5O_MROW), SPREV, a.in[I_S5D] + l * 1024, BR, it, lane);
        }
        SEAM(pb + 4);
        PHASE(pb + 5, 6) { pg8::Gemm g{BR, (const bf16_t*)(wl + WO_WBR), NBR, 1024, 1024}; pg8::BranchOrder S{G, bid, DUP_BR};
            pg8::EpiBranch E{PROJ, Y, MBF}; pg8::gemm_phase(lds, g, S, E, tid); }
        SEAM(pb + 5);
        PHASE(pb + 6, 7) { pg8::Gemm g{MBF, (const bf16_t*)(wl + WO_WO), DM, DM, DM}; pg8::StaticOrder S; S.init(MTOK, DM, G, bid); S.dup = DUP_WO;
            pg8::EpiResid E{xin, modl + 2 * 2048, Y}; pg8::gemm_phase(lds, g, S, E, tid); }
        SEAM(pb + 6);
        PHASE(pb + 7, 8) ln_phase(Y, a.in[I_LN1G] + l * DM, a.in[I_LN1B] + l * DM, X1, modl + 4 * 2048, modl + 3 * 2048, H, gw, ngw, lane);
        SEAM(pb + 7);
        PHASE(pb + 8, 9) { pg8::Gemm g{H, (const bf16_t*)(wl + WO_WGU), DM, DM, DM}; pg8::StaticOrder S; S.init(MTOK, NGU, G, bid); S.dup = DUP_GU;
            pg8::EpiGateUp E{ACT}; pg8::gemm_phase(lds, g, S, E, tid); }
        SEAM(pb + 8);
        PHASE(pb + 9, 10) { pg8::Gemm g{ACT, (const bf16_t*)(wl + WO_WD), DFF, DFF, DFF}; pg8::StaticOrder S; S.init(MTOK, DM, G, bid); S.dup = DUP_DOWN;
            pg8::EpiResid E{X1, modl + 5 * 2048, Y}; pg8::gemm_phase(lds, g, S, E, tid); }
        SEAM(pb + 9);
        PHASE(pb + 10, 11) { const float* modn = MOD + (size_t)(l + 1) * 4 * 12288;
            ln_phase(Y, a.in[I_LN2G] + l * DM, a.in[I_LN2B] + l * DM, a.out, l == 0 ? modn + 2048 : nullptr, l == 0 ? modn : nullptr, H, gw, ngw, lane); }
        if (l == 0) SEAM(pb + 10);
    }
#undef IN
#undef SEAM
}

#ifndef MK_SPLIT
#define MK_SPLIT 0
#endif
extern "C" void kernel_launch(void* const* d_in, const int* in_sizes, int n_in, void* d_out, int out_size, void* d_ws, size_t ws_size, hipStream_t stream) {
    static int grid = 0;
    if (grid == 0) {
        if (n_in != 30 || ws_size < WS_END) { fprintf(stderr, "kernel_launch: unexpected n_in %d or ws_size %zu (< %zu)\n", n_in, ws_size, (size_t)WS_END); grid = -1; return; }
        int dev = 0, cus = 0, per_cu = 0;
        hipGetDevice(&dev); hipDeviceGetAttribute(&cus, hipDeviceAttributeMultiprocessorCount, dev);
        if (hipFuncSetAttribute((const void*)mk_fwd, hipFuncAttributeMaxDynamicSharedMemorySize, LDS_BYTES) != hipSuccess) { fprintf(stderr, "kernel_launch: hipFuncSetAttribute failed\n"); grid = -1; return; }
        if (hipOccupancyMaxActiveBlocksPerMultiprocessor(&per_cu, (const void*)mk_fwd, 512, LDS_BYTES) != hipSuccess || per_cu < 1) { fprintf(stderr, "kernel_launch: occupancy query says %d\n", per_cu); per_cu = 1; }
        (void)hipGetLastError();
        grid = cus > 256 ? 256 : cus;
    }
    if (grid < 0) return;
    if (hipMemsetAsync((char*)d_ws + WS_CTL, 0, CTL_BYTES, stream) != hipSuccess) { fprintf(stderr, "memset failed\n"); return; }
    Args a{};
    for (int i = 0; i < 30; ++i) a.in[i] = (const float*)d_in[i];
    a.out = (float*)d_out; a.ws = (unsigned char*)d_ws;
#if MK_SPLIT
    for (int ph = 0; ph < NPH; ++ph) { a.ph_lo = ph; a.ph_hi = ph + 1; hipLaunchKernelGGL(mk_fwd, dim3(grid), dim3(512), LDS_BYTES, stream, a); }
#else
    a.ph_lo = 0; a.ph_hi = NPH;
    void* args[] = {&a};
    hipError_t e = hipLaunchCooperativeKernel((const void*)mk_fwd, dim3(grid), dim3(512), args, LDS_BYTES, stream);
    if (e != hipSuccess) fprintf(stderr, "cooperative launch failed: %s (grid %d)\n", hipGetErrorString(e), grid);
#endif
}
```
